# Optimizing an MI355X kernel written in HIP

```python
import jax, jax.numpy as jnp
from jax import lax
import numpy as np

D_MODEL = 2048
BATCH = 2
SEQ = 4096
DEPTH = 2

MEM_LEN = 256
EPS = 1e-6
D_FF = 5632
MLA_HEADS = 8
MLA_Q_RANK = 512
MLA_KV_RANK = 512
MLA_NOPE = 128
MLA_ROPE = 64
MLA_V = 128
MLA_WIDTH = MLA_HEADS * MLA_V
ROPE_THETA = 10000.0
Q_BLOCK = 128
GLA_HEADS = 4
GLA_DK = 64
GLA_DV = 128
GLA_WIDTH = GLA_HEADS * GLA_DV
GLA_GATE_RANK = 16
GLA_TAU = 16.0
GLA_CHUNK = 64
CONV_DIM = 512
CONV_WIDTH = 3
X_HEADS = 4
X_HEAD_DIM = D_MODEL // X_HEADS
N_BRANCH = 3
IN_SPLITS = (MLA_Q_RANK, MLA_KV_RANK, MLA_ROPE,
             GLA_HEADS * GLA_DK, GLA_HEADS * GLA_DK, GLA_WIDTH, GLA_WIDTH, GLA_GATE_RANK,
             3 * CONV_DIM, N_BRANCH * D_MODEL)
D_IN_PROJ = sum(IN_SPLITS)

kernel_name = "hybrid_mla_gla_shortconv_gated_macaron"


def _split(z, sizes):
    outs, off = [], 0
    for n in sizes:
        outs.append(z[..., off:off + n])
        off += n
    return outs


def rmsnorm(x, g):
    xf = x.astype(jnp.float32)
    y = xf * lax.rsqrt(jnp.mean(xf * xf, axis=-1, keepdims=True) + EPS)
    return (y * g.astype(jnp.float32)).astype(x.dtype)


def swiglu(x, w_in, w_out):
    gate, up = jnp.split(x @ w_in, 2, axis=-1)
    return (jax.nn.silu(gate) * up) @ w_out


def rope_tables(seq):
    inv_freq = 1.0 / (ROPE_THETA ** (jnp.arange(0, MLA_ROPE, 2, dtype=jnp.float32) / MLA_ROPE))
    ang = jnp.arange(seq, dtype=jnp.float32)[:, None] * inv_freq[None, :]
    return jnp.cos(ang), jnp.sin(ang)


def apply_rope(x, cos, sin):
    x1, x2 = jnp.split(x, 2, axis=-1)
    cos = cos.astype(x.dtype)
    sin = sin.astype(x.dtype)
    return jnp.concatenate([x1 * cos - x2 * sin, x2 * cos + x1 * sin], axis=-1)


def mla(c_q, c_kv, k_rope, q_norm_g, kv_norm_g, w_uq, w_ukv, cos, sin):
    B, S, _ = c_q.shape
    q = (rmsnorm(c_q, q_norm_g) @ w_uq).reshape(B, S, MLA_HEADS, MLA_NOPE + MLA_ROPE)
    q_nope, q_pe = q[..., :MLA_NOPE], q[..., MLA_NOPE:]
    kv = (rmsnorm(c_kv, kv_norm_g) @ w_ukv).reshape(B, S, MLA_HEADS, MLA_NOPE + MLA_V)
    k_nope, v = kv[..., :MLA_NOPE], kv[..., MLA_NOPE:]
    q_pe = apply_rope(q_pe, cos[:, None, :], sin[:, None, :])
    k_pe = apply_rope(k_rope, cos, sin)
    scale = (MLA_NOPE + MLA_ROPE) ** -0.5
    nb = S // Q_BLOCK
    qn_b = q_nope.reshape(B, nb, Q_BLOCK, MLA_HEADS, MLA_NOPE).transpose(1, 0, 2, 3, 4)
    qp_b = q_pe.reshape(B, nb, Q_BLOCK, MLA_HEADS, MLA_ROPE).transpose(1, 0, 2, 3, 4)
    k_pos = jnp.arange(S)

    def block(args):
        i, qn, qp = args
        s = (jnp.einsum('bqhd,bkhd->bhqk', qn, k_nope)
             + jnp.einsum('bqhr,bkr->bhqk', qp, k_pe)).astype(jnp.float32) * scale
        q_pos = i * Q_BLOCK + jnp.arange(Q_BLOCK)
        s = jnp.where(q_pos[:, None] >= k_pos[None, :], s, -jnp.inf)
        p = jax.nn.softmax(s, axis=-1).astype(v.dtype)
        return jnp.einsum('bhqk,bkhd->bqhd', p, v)

    o = lax.map(block, (jnp.arange(nb), qn_b, qp_b))
    return o.transpose(1, 0, 2, 3, 4).reshape(B, S, MLA_WIDTH)


def gla(q, k, v, r, a_low, w_a2, b_a, norm_g):
    B, S, _ = q.shape
    H, DK, DV, C = GLA_HEADS, GLA_DK, GLA_DV, GLA_CHUNK
    N = S // C
    f32 = jnp.float32
    log_a = jax.nn.log_sigmoid((a_low @ w_a2 + b_a).astype(f32)) / GLA_TAU

    def heads(t, d):
        return t.astype(f32).reshape(B, N, C, H, d).transpose(0, 3, 1, 2, 4)

    qh = heads(q, DK) * DK ** -0.5
    kh = heads(k, DK)
    vh = heads(v, DV)
    bcum = jnp.cumsum(heads(log_a, DK), axis=3)
    causal = jnp.tril(jnp.ones((C, C), dtype=bool))[:, :, None]
    decay = jnp.exp(jnp.where(causal, bcum[..., :, None, :] - bcum[..., None, :, :], -jnp.inf))
    attn = jnp.einsum('bhntd,bhnsd,bhntsd->bhnts', qh, kh, decay)
    o_intra = jnp.einsum('bhnts,bhnsv->bhntv', attn, vh)
    b_last = bcum[..., -1:, :]
    q_dec = qh * jnp.exp(bcum)
    k_dec = kh * jnp.exp(b_last - bcum)
    chunk_decay = jnp.exp(b_last[..., 0, :])

    def step(state, xs):
        qd, kd, vc, cd = xs
        o = jnp.einsum('bhtd,bhdv->bhtv', qd, state)
        state = cd[..., None] * state + jnp.einsum('bhsd,bhsv->bhdv', kd, vc)
        return state, o

    xs = (jnp.moveaxis(q_dec, 2, 0), jnp.moveaxis(k_dec, 2, 0),
          jnp.moveaxis(vh, 2, 0), jnp.moveaxis(chunk_decay, 2, 0))
    _, o_inter = lax.scan(step, jnp.zeros((B, H, DK, DV), f32), xs)
    o = o_intra + jnp.moveaxis(o_inter, 0, 2)
    o = o.transpose(0, 2, 3, 1, 4).reshape(B, S, H, DV)
    o = o * lax.rsqrt(jnp.mean(o * o, axis=-1, keepdims=True) + EPS)
    o = o.reshape(B, S, GLA_WIDTH) * norm_g.astype(f32)
    return (o * jax.nn.silu(r.astype(f32))).astype(q.dtype)


def short_conv(bch, conv_w):
    b_g, c_g, h_in = jnp.split(bch, 3, axis=-1)
    z = c_g * h_in
    y = lax.conv_general_dilated(z, conv_w.astype(z.dtype), window_strides=(1,),
                                 padding=((CONV_WIDTH - 1, 0),),
                                 dimension_numbers=('NWC', 'WIO', 'NWC'),
                                 feature_group_count=CONV_DIM)
    return b_g * y


def cross_attn(hn, memn, w_q, w_kv, w_o):
    B, S, _ = hn.shape
    M = memn.shape[1]
    q = (hn @ w_q).reshape(B, S, X_HEADS, X_HEAD_DIM)
    k, v = jnp.split(memn @ w_kv, 2, axis=-1)
    k = k.reshape(B, M, X_HEADS, X_HEAD_DIM)
    v = v.reshape(B, M, X_HEADS, X_HEAD_DIM)
    s = jnp.einsum('bshd,bmhd->bhsm', q, k).astype(jnp.float32) * X_HEAD_DIM ** -0.5
    p = jax.nn.softmax(s, axis=-1).astype(v.dtype)
    o = jnp.einsum('bhsm,bmhd->bshd', p, v).reshape(B, S, D_MODEL)
    return o @ w_o


def setup_inputs(seed: int = 0) -> dict:
    key = jax.random.key(seed)
    k = jax.random.split(key, 29)
    L, D, F = DEPTH, D_MODEL, D_FF
    f32 = jnp.float32

    def w(kk, shape, fan_in):
        return jax.random.normal(kk, shape, f32) * fan_in ** -0.5

    def gain(kk, shape):
        return 1.0 + 0.02 * jax.random.normal(kk, shape, f32)

    def bias(kk, shape, s):
        return s * jax.random.normal(kk, shape, f32)

    return {
        "x": jax.random.normal(k[0], (BATCH, SEQ, D), f32),
        "mem": jax.random.normal(k[1], (BATCH, MEM_LEN, D), f32),
        "ffn1_norm": gain(k[2], (L, D)),
        "ffn1_w_in": w(k[3], (L, D, 2 * F), D),
        "ffn1_w_out": w(k[4], (L, F, D), F),
        "mix_norm": gain(k[5], (L, D)),
        "mix_w_in": w(k[6], (L, D, D_IN_PROJ), D),
        "mix_b_gate": bias(k[7], (L, N_BRANCH * D), 0.02),
        "mla_q_norm": gain(k[8], (L, MLA_Q_RANK)),
        "mla_kv_norm": gain(k[9], (L, MLA_KV_RANK)),
        "mla_w_uq": w(k[10], (L, MLA_Q_RANK, MLA_HEADS * (MLA_NOPE + MLA_ROPE)), MLA_Q_RANK),
        "mla_w_ukv": w(k[11], (L, MLA_KV_RANK, MLA_HEADS * (MLA_NOPE + MLA_V)), MLA_KV_RANK),
        "mla_w_proj": w(k[12], (L, MLA_WIDTH, D), MLA_WIDTH),
        "gla_w_a2": w(k[13], (L, GLA_GATE_RANK, GLA_HEADS * GLA_DK), GLA_GATE_RANK),
        "gla_b_a": bias(k[14], (L, GLA_HEADS * GLA_DK), 0.1),
        "gla_norm": gain(k[15], (L, GLA_WIDTH)),
        "gla_w_proj": w(k[16], (L, GLA_WIDTH, D), GLA_WIDTH),
        "conv_w": w(k[17], (L, CONV_WIDTH, 1, CONV_DIM), CONV_WIDTH),
        "conv_w_proj": w(k[18], (L, CONV_DIM, D), CONV_DIM),
        "mix_w_out": w(k[19], (L, D, D), D),
        "xattn_norm": gain(k[20], (L, D)),
        "mem_norm": gain(k[21], (L, D)),
        "xattn_w_q": w(k[22], (L, D, D), D),
        "xattn_w_kv": w(k[23], (L, D, 2 * D), D),
        "xattn_w_o": w(k[24], (L, D, D), D),
        "ffn2_norm": gain(k[25], (L, D)),
        "ffn2_w_in": w(k[26], (L, D, 2 * F), D),
        "ffn2_w_out": w(k[27], (L, F, D), F),
        "final_norm": gain(k[28], (D,)),
    }


def reference(x, mem, ffn1_norm, ffn1_w_in, ffn1_w_out, mix_norm, mix_w_in, mix_b_gate,
              mla_q_norm, mla_kv_norm, mla_w_uq, mla_w_ukv, mla_w_proj,
              gla_w_a2, gla_b_a, gla_norm, gla_w_proj, conv_w, conv_w_proj, mix_w_out,
              xattn_norm, mem_norm, xattn_w_q, xattn_w_kv, xattn_w_o,
              ffn2_norm, ffn2_w_in, ffn2_w_out, final_norm):
    cos, sin = rope_tables(x.shape[1])
    h = x
    for l in range(DEPTH):
        h = h + 0.5 * swiglu(rmsnorm(h, ffn1_norm[l]), ffn1_w_in[l], ffn1_w_out[l])
        u = rmsnorm(h, mix_norm[l])
        z = u @ mix_w_in[l]
        (c_q, c_kv, k_rope, g_q, g_k, g_v, g_r, a_low, conv_in, gate_pre) = _split(z, IN_SPLITS)
        y_mla = mla(c_q, c_kv, k_rope, mla_q_norm[l], mla_kv_norm[l],
                    mla_w_uq[l], mla_w_ukv[l], cos, sin) @ mla_w_proj[l]
        y_gla = gla(g_q, g_k, g_v, g_r, a_low, gla_w_a2[l], gla_b_a[l], gla_norm[l]) @ gla_w_proj[l]
        y_conv = short_conv(conv_in, conv_w[l]) @ conv_w_proj[l]
        gates = jax.nn.sigmoid((gate_pre + mix_b_gate[l]).astype(jnp.float32)).astype(h.dtype)
        g_mla, g_gla, g_conv = jnp.split(gates, N_BRANCH, axis=-1)
        merged = g_mla * y_mla + g_gla * y_gla + g_conv * y_conv
        h = h + merged @ mix_w_out[l]
        h = h + cross_attn(rmsnorm(h, xattn_norm[l]), rmsnorm(mem, mem_norm[l]),
                           xattn_w_q[l], xattn_w_kv[l], xattn_w_o[l])
        h = h + 0.5 * swiglu(rmsnorm(h, ffn2_norm[l]), ffn2_w_in[l], ffn2_w_out[l])
    return rmsnorm(h, final_norm)
```

```cpp
#include <hip/hip_runtime.h>
#include <hip/hip_cooperative_groups.h>
#include <cstdio>
#include <cstdint>
namespace cg = cooperative_groups;

#define LAS __attribute__((address_space(3)))
typedef unsigned short bf16_t;
typedef short bf16x8 __attribute__((ext_vector_type(8)));
typedef float f32x4 __attribute__((ext_vector_type(4)));
typedef float f32x2 __attribute__((ext_vector_type(2)));
typedef float f32x16 __attribute__((ext_vector_type(16)));
typedef unsigned u32x4 __attribute__((ext_vector_type(4)));
typedef unsigned u32x2 __attribute__((ext_vector_type(2)));

constexpr int T_ = 8192, D_ = 2048, F_ = 5632, S_ = 4096, NB_ = 2;
constexpr int ZP = 10496, NZIN = 10320;
constexpr int OFF_CQ = 0, OFF_CKV = 512, OFF_KR = 1024, OFF_GQ = 1088, OFF_GK = 1344, OFF_GV = 1600, OFF_GR = 2112, OFF_AL = 2624,
              OFF_CV = 2640, OFF_GATE = 4176;
constexpr float EPS_ = 1e-6f;
constexpr int NTHR = 512;
constexpr int LDS_BYTES = 147456;

constexpr size_t al256(size_t x) { return (x + 255) & ~(size_t)255; }
constexpr size_t WS_W1I = 0;
constexpr size_t WS_W1O = WS_W1I + al256((size_t)2 * F_ * D_ * 2);
constexpr size_t WS_WIN = WS_W1O + al256((size_t)D_ * F_ * 2);
constexpr size_t WS_WUQ = WS_WIN + al256((size_t)ZP * D_ * 2);
constexpr size_t WS_WUK = WS_WUQ + al256((size_t)1536 * 512 * 2);
constexpr size_t WS_WUV = WS_WUK + al256((size_t)1024 * 512 * 2);
constexpr size_t WS_WPM = WS_WUV + al256((size_t)1024 * 512 * 2);
constexpr size_t WS_WPG = WS_WPM + al256((size_t)2048 * 1024 * 2);
constexpr size_t WS_WPC = WS_WPG + al256((size_t)2048 * 512 * 2);
constexpr size_t WS_WMO = WS_WPC + al256((size_t)2048 * 512 * 2);
constexpr size_t WS_WXQ = WS_WMO + al256((size_t)2048 * 2048 * 2);
constexpr size_t WS_WXK = WS_WXQ + al256((size_t)2048 * 2048 * 2);
constexpr size_t WS_WXV = WS_WXK + al256((size_t)2048 * 2048 * 2);
constexpr size_t WS_WXO = WS_WXV + al256((size_t)2048 * 2048 * 2);
constexpr size_t WS_W2I = WS_WXO + al256((size_t)2048 * 2048 * 2);
constexpr size_t WS_W2O = WS_W2I + al256((size_t)2 * F_ * D_ * 2);
constexpr size_t WS_XN  = WS_W2O + al256((size_t)D_ * F_ * 2);
constexpr size_t WS_Z   = WS_XN + al256((size_t)T_ * D_ * 2);
constexpr size_t WS_HB  = WS_Z;
constexpr size_t WS_CQN = WS_Z + al256((size_t)T_ * ZP * 2);
constexpr size_t WS_CKVN = WS_CQN + al256((size_t)T_ * 512 * 2);
constexpr size_t WS_KPE = WS_CKVN + al256((size_t)T_ * 512 * 2);
constexpr size_t WS_YC  = WS_KPE + al256((size_t)T_ * 64 * 2);
constexpr size_t WS_QB  = WS_YC + al256((size_t)T_ * 512 * 2);
constexpr size_t WS_KN  = WS_QB + al256((size_t)T_ * 1536 * 2);
constexpr size_t WS_VT  = WS_KN + al256((size_t)T_ * 1024 * 2);
constexpr size_t WS_OM  = WS_VT + al256((size_t)T_ * 1024 * 2);
constexpr size_t WS_OG  = WS_OM + al256((size_t)T_ * 1024 * 2);
constexpr size_t WS_OI  = WS_OG + al256((size_t)T_ * 512 * 2);
constexpr size_t WS_KV  = WS_OI + al256((size_t)T_ * 512 * 4);
constexpr size_t WS_ST  = WS_KV + al256((size_t)8 * 64 * 8192 * 4);
constexpr size_t WS_CD  = WS_ST + al256((size_t)8 * 64 * 8192 * 4);
constexpr size_t WS_QD  = WS_CD + al256((size_t)8 * 64 * 64 * 4);
constexpr size_t WS_MG  = WS_QD + al256((size_t)T_ * 256 * 4);
constexpr size_t WS_ACT = WS_MG;
constexpr size_t WS_QX  = WS_MG + al256((size_t)T_ * D_ * 4);
constexpr size_t WS_SX  = WS_QX + al256((size_t)T_ * D_ * 2);
constexpr size_t WS_PX  = WS_SX + al256((size_t)T_ * 1024 * 4);
constexpr size_t WS_OX  = WS_PX + al256((size_t)T_ * 1024 * 2);
constexpr size_t WS_MEMN = WS_OX + al256((size_t)T_ * D_ * 2);
constexpr size_t WS_KM  = WS_MEMN + al256((size_t)512 * D_ * 2);
constexpr size_t WS_VMT = WS_KM + al256((size_t)512 * D_ * 2);
constexpr size_t WS_CS  = WS_VMT + al256((size_t)512 * D_ * 2);
constexpr size_t WS_HBF = WS_CS + al256((size_t)4096 * 32 * 2 * 4);
constexpr size_t WS_SS  = WS_HBF + al256((size_t)T_ * D_ * 2);
constexpr size_t WS_CTL = WS_SS + al256((size_t)3 * 4 * T_ * 32 * 4);
constexpr size_t CTL_BYTES = 32768;
constexpr int CW_PANEL = 4096;
constexpr size_t WS_END = WS_CTL + CTL_BYTES;
constexpr int LDS_ST_OFF = 131072 + 320;
constexpr int LDS_RS_OFF = 131072 + 1024;

__device__ __forceinline__ unsigned cvt_pk_bf16(float lo, float hi) { unsigned r; asm volatile("v_cvt_pk_bf16_f32 %0, %1, %2" : "=v"(r) : "v"(lo), "v"(hi)); return r; }
__device__ __forceinline__ float bf2f(unsigned b) { return __uint_as_float(b << 16); }
__device__ __forceinline__ float bflo(unsigned w) { return __uint_as_float(w << 16); }
__device__ __forceinline__ float bfhi(unsigned w) { return __uint_as_float(w & 0xffff0000u); }
__device__ __forceinline__ int tid_opaque() { int t = threadIdx.x; asm volatile("" : "+v"(t)); return t; }
__device__ __forceinline__ float wave_sum(float v) {
#pragma unroll
    for (int o = 1; o < 64; o <<= 1) v += __shfl_xor(v, o);
    return v;
}
__device__ __forceinline__ float wave_max(float v) {
#pragma unroll
    for (int o = 1; o < 64; o <<= 1) v = fmaxf(v, __shfl_xor(v, o));
    return v;
}

namespace pg8 {
constexpr int BM = 256, BK = 64, HALF = 128, HTB = HALF * BK * 2, STAGE_BYTES = 8 * HTB, NXCD = 8, WGM = 8;
__host__ __device__ __forceinline__ int lds_byte(int r, int c) { const int st = (r >> 4) * 2 + (c >> 5), rr = r & 15, cc = c & 31, ob = rr * 64 + cc * 2; return st * 1024 + (ob ^ (((ob >> 9) & 1) << 5)); }
__host__ __device__ __forceinline__ void stage_rc(int b, int& R, int& C) { const int st = b / 1024, sb = b % 1024, swz = sb ^ (((sb >> 9) & 1) << 5); R = (st >> 1) * 16 + swz / 64; C = (st & 1) * 32 + (swz % 64) / 2; }
__host__ __device__ __forceinline__ int perm32(int rho) { const int n = rho >> 4, i = rho & 15; return 8 * (i >> 2) + 4 * n + (i & 3); }

struct Unit { int pm, pn, z, grp, idx; };
struct Gemm { const bf16_t* A; const bf16_t* Bt; int M, N, K, lda, ldb, nz, nzh; long sAb, sAh, sBb, sBh;
              const bf16_t* A1; const bf16_t* B1; int nM1, cnt1; const bf16_t* A2; const bf16_t* B2; int nM2, cnt2; };

struct StaticOrder {
    int nM, nN, nwg, G, c, nz, nM1, cnt1, nM2, cnt2, fmode, fz, fpm;
    __device__ void init(int M, int N, int nz_, int G_, int c_, int nM1_, int cnt1_, int nM2_, int cnt2_) { nM = M / BM; nN = N / BM; nwg = nM * nN; nz = nz_; G = G_; c = c_; nM1 = nM1_; cnt1 = cnt1_; nM2 = nM2_; cnt2 = cnt2_; fmode = 0; fz = 0; fpm = 0; }
    __device__ bool next(int i, Unit& u) const {
        u.idx = i;
        if (fmode != 0) { if (fmode == 2 || i >= nN) return false; u.z = fz; u.pm = fpm; u.pn = i; u.grp = 0; return true; }
        const long L = (long)i * G + c;
        if (L >= (long)nwg * nz) {
            int e = (int)(L - (long)nwg * nz); u.z = 0;
            if (e < cnt1) { u.grp = 1; u.pm = e % nM1; u.pn = e / nM1; return true; }
            e -= cnt1;
            if (e < cnt2) { u.grp = 2; u.pm = e % nM2; u.pn = e / nM2; return true; }
            return false;
        }
        u.grp = 0;
        u.z = (int)(L / nwg);
        int wgid = (int)(L % nwg); { const int q = nwg / NXCD, r = nwg % NXCD, xcd = wgid % NXCD, off = wgid / NXCD; wgid = (xcd < r ? xcd * (q + 1) : r * (q + 1) + (xcd - r) * q) + off; }
        const int nig = WGM * nN, gid = wgid / nig, fm = gid * WGM, gsz = (nM - fm) < WGM ? (nM - fm) : WGM;
        u.pm = fm + ((wgid % nig) % gsz); u.pn = (wgid % nig) / gsz; return true;
    }
};

struct EpiBase { static constexpr bool HOOK = false; int nzh; long sCb, sCh; bf16_t* O1; int ldc1; bf16_t* O2; int ldc2;
    __device__ __forceinline__ long zoff(const Unit& u) const { return (long)(u.z / nzh) * sCb + (long)(u.z % nzh) * sCh; } };
__device__ __forceinline__ float rstd_row(const float* ssp, int row) {
    const f32x4* p = (const f32x4*)(ssp + (size_t)row * 32); f32x4 a = p[0];
#pragma unroll
    for (int i = 1; i < 8; ++i) a += p[i];
    return 1.0f / sqrtf(((a[0] + a[1]) + (a[2] + a[3])) * (1.0f / 2048.0f) + EPS_);
}
__device__ __forceinline__ void store_bf16_perm(const f32x4 (&acc)[2][2][4][2], bf16_t* base, int ldc, float scale0, const LAS float* rowss, const Unit& u, int wr, int wc, int fr, int fq) {
    const int row0 = u.pm * BM + wr * 64 + fr; const int col0 = u.pn * BM + wc * 32 + 8 * fq;
#pragma unroll
    for (int ai = 0; ai < 2; ++ai)
#pragma unroll
        for (int m = 0; m < 4; ++m) { bf16_t* rowp = base + (size_t)(row0 + ai * HALF + m * 16) * ldc + col0;
            const float scale = rowss ? scale0 * rowss[u.idx * 256 + wr * 64 + fr + ai * HALF + m * 16] : scale0;
#pragma unroll
            for (int bj = 0; bj < 2; ++bj) { const f32x4 v0 = acc[ai][bj][m][0] * scale, v1 = acc[ai][bj][m][1] * scale;
                u32x4 w; w.x = cvt_pk_bf16(v0[0], v0[1]); w.y = cvt_pk_bf16(v0[2], v0[3]); w.z = cvt_pk_bf16(v1[0], v1[1]); w.w = cvt_pk_bf16(v1[2], v1[3]);
                *(u32x4*)(rowp + bj * HALF) = w; } }
}

struct EpiBf16 : EpiBase {
    static constexpr bool PERM = true;
    bf16_t* O; const LAS float* rowss; int ldc; float scale;
    __device__ __forceinline__ void operator()(const f32x4 (&acc)[2][2][4][2], const Unit& u, int wr, int wc, int fr, int fq) const {
        bf16_t* o0 = O + zoff(u); bf16_t* o1 = O1; bf16_t* o2 = O2; int l0 = ldc, l1 = ldc1, l2 = ldc2;
        asm volatile("" : "+s"(o0), "+s"(o1), "+s"(o2), "+s"(l0), "+s"(l1), "+s"(l2));
        bf16_t* base = u.grp == 0 ? o0 : (u.grp == 1 ? o1 : o2); const int ld = u.grp == 0 ? l0 : (u.grp == 1 ? l1 : l2);
        store_bf16_perm(acc, base, ld, scale, u.grp == 0 ? rowss : nullptr, u, wr, wc, fr, fq);
    }
};
__device__ __forceinline__ float sigm(float x) { return __builtin_amdgcn_rcpf(1.0f + __builtin_amdgcn_exp2f(-1.4426950408889634f * x)); }
__device__ __forceinline__ float silu_mul(float g, float u) { return g * u * sigm(g); }
struct EpiSwiglu : EpiBase {
    static constexpr bool PERM = true;
    bf16_t* O; int ldc; const LAS float* rowss;
    __device__ __forceinline__ void operator()(const f32x4 (&acc)[2][2][4][2], const Unit& u, int wr, int wc, int fr, int fq) const {
        if (u.grp != 0) { bf16_t* o1 = O1; bf16_t* o2 = O2; int l1 = ldc1, l2 = ldc2; asm volatile("" : "+s"(o1), "+s"(o2), "+s"(l1), "+s"(l2));
            store_bf16_perm(acc, u.grp == 1 ? o1 : o2, u.grp == 1 ? l1 : l2, 1.f, nullptr, u, wr, wc, fr, fq); return; }
        const int row0 = u.pm * BM + wr * 64 + fr; const int col0 = u.pn * HALF + wc * 32 + 8 * fq;
#pragma unroll
        for (int ai = 0; ai < 2; ++ai)
#pragma unroll
            for (int m = 0; m < 4; ++m) { bf16_t* rowp = O + (size_t)(row0 + ai * HALF + m * 16) * ldc + col0;
                const float rs = rowss[u.idx * 256 + wr * 64 + fr + ai * HALF + m * 16];
                const f32x4 g0 = acc[ai][0][m][0] * rs, g1 = acc[ai][0][m][1] * rs, u0 = acc[ai][1][m][0] * rs, u1 = acc[ai][1][m][1] * rs;
                u32x4 w; w.x = cvt_pk_bf16(silu_mul(g0[0], u0[0]), silu_mul(g0[1], u0[1])); w.y = cvt_pk_bf16(silu_mul(g0[2], u0[2]), silu_mul(g0[3], u0[3]));
                w.z = cvt_pk_bf16(silu_mul(g1[0], u1[0]), silu_mul(g1[1], u1[1])); w.w = cvt_pk_bf16(silu_mul(g1[2], u1[2]), silu_mul(g1[3], u1[3]));
                *(u32x4*)rowp = w; }
    }
};
struct EpiResid : EpiBase {
    static constexpr bool PERM = true;
    const float* resid; float* out; bf16_t* hb; float* ss; int zrows; int ldc; float scale;
    __device__ __forceinline__ void operator()(const f32x4 (&acc)[2][2][4][2], const Unit& u, int wr, int wc, int fr, int fq) const {
        const int col0 = u.pn * BM + wc * 32 + 8 * fq;
        const float* const resid = this->resid; float* const out = this->out; const int ldc = this->ldc; const float scale = this->scale; bf16_t* const hb = this->hb; float* const ss = this->ss; const int zrows = this->zrows;
#pragma unroll
        for (int ai = 0; ai < 2; ++ai)
#pragma unroll
            for (int m = 0; m < 4; ++m) { const int row = u.z * zrows + u.pm * BM + ai * HALF + wr * 64 + m * 16 + fr; const size_t off = (size_t)row * ldc + col0;
                float sq = 0.f;
#pragma unroll
                for (int bj = 0; bj < 2; ++bj) { const f32x4 b0 = *(const f32x4*)(resid + off + bj * HALF), b1 = *(const f32x4*)(resid + off + bj * HALF + 4);
                    const f32x4 v0 = b0 + acc[ai][bj][m][0] * scale, v1 = b1 + acc[ai][bj][m][1] * scale;
                    *(f32x4*)(out + off + bj * HALF) = v0; *(f32x4*)(out + off + bj * HALF + 4) = v1;
                    u32x4 w; w.x = cvt_pk_bf16(v0[0], v0[1]); w.y = cvt_pk_bf16(v0[2], v0[3]); w.z = cvt_pk_bf16(v1[0], v1[1]); w.w = cvt_pk_bf16(v1[2], v1[3]); *(u32x4*)(hb + off + bj * HALF) = w;
                    sq += ((v0[0] * v0[0] + v0[1] * v0[1]) + (v0[2] * v0[2] + v0[3] * v0[3])) + ((v1[0] * v1[0] + v1[1] * v1[1]) + (v1[2] * v1[2] + v1[3] * v1[3])); }
                sq += __shfl_xor(sq, 16); sq += __shfl_xor(sq, 32);
                if (fq == 0) ss[(size_t)row * 32 + u.pn * 4 + wc] = sq;
                }
    }
};
struct EpiFinal : EpiBase {
    static constexpr bool PERM = true;
    const float* resid; float* out; const float* g; float* xpart; unsigned* cnt; LAS float* tab; int ldc; float scale;
    __device__ __forceinline__ void operator()(const f32x4 (&acc_)[2][2][4][2], const Unit& u, int wr, int wc, int fr_, int fq) const {
        int fr = fr_; asm volatile("" : "+v"(fr));
        f32x4 (&acc)[2][2][4][2] = const_cast<f32x4 (&)[2][2][4][2]>(acc_);
        const int col0 = u.pn * BM + wc * 32 + 8 * fq; const int lane = fq * 16 + fr; const int tid = (wr * 4 + wc) * 64 + lane;
        const float* const resid = this->resid; float* const out = this->out; const int ldc = this->ldc; const float scale = this->scale;
#pragma unroll
        for (int ai = 0; ai < 2; ++ai)
#pragma unroll
            for (int m = 0; m < 4; ++m) { const int row = u.pm * BM + ai * HALF + wr * 64 + m * 16 + fr; const size_t off = (size_t)row * ldc + col0; float sq = 0.f;
#pragma unroll
                for (int bj = 0; bj < 2; ++bj) { const f32x4 b0 = *(const f32x4*)(resid + off + bj * HALF), b1 = *(const f32x4*)(resid + off + bj * HALF + 4);
                    const f32x4 v0 = b0 + acc[ai][bj][m][0] * scale, v1 = b1 + acc[ai][bj][m][1] * scale; acc[ai][bj][m][0] = v0; acc[ai][bj][m][1] = v1;
                    sq += ((v0[0] * v0[0] + v0[1] * v0[1]) + (v0[2] * v0[2] + v0[3] * v0[3])) + ((v1[0] * v1[0] + v1[1] * v1[1]) + (v1[2] * v1[2] + v1[3] * v1[3])); }
                sq += __shfl_xor(sq, 16); sq += __shfl_xor(sq, 32);
                if (fq == 0) __hip_atomic_store((unsigned*)(xpart + (size_t)row * 32 + u.pn * 4 + wc), __float_as_uint(sq), __ATOMIC_RELAXED, __HIP_MEMORY_SCOPE_AGENT); }
        asm volatile("s_waitcnt vmcnt(0)" ::: "memory");
        unsigned* const pc = cnt + 64 * u.pm;
        if (lane == 0) __hip_atomic_fetch_add(pc, 1u, __ATOMIC_RELAXED, __HIP_MEMORY_SCOPE_AGENT);
        if (tid < 64) {
            unsigned sp = 0;
            while ((unsigned)__builtin_amdgcn_readfirstlane(__hip_atomic_load(pc, __ATOMIC_RELAXED, __HIP_MEMORY_SCOPE_AGENT)) < 64u) { __builtin_amdgcn_s_sleep(2); if (++sp > (1u << 22)) break; }
            __builtin_amdgcn_fence(__ATOMIC_ACQUIRE, "agent");
        }
        asm volatile("s_waitcnt vmcnt(0) lgkmcnt(0)" ::: "memory"); __builtin_amdgcn_s_barrier(); asm volatile("" ::: "memory");
        {
            const int r = tid >> 1; const unsigned* pp = (const unsigned*)(xpart + (size_t)(u.pm * BM + r) * 32 + (tid & 1) * 16); float sm = 0.f;
#pragma unroll
            for (int i = 0; i < 16; ++i) sm += __uint_as_float(__hip_atomic_load(pp + i, __ATOMIC_RELAXED, __HIP_MEMORY_SCOPE_AGENT));
            sm += __shfl_xor(sm, 1);
            if ((tid & 1) == 0) tab[r] = 1.0f / sqrtf(sm * (1.0f / 2048.0f) + EPS_);
        }
        asm volatile("s_waitcnt lgkmcnt(0)" ::: "memory"); __builtin_amdgcn_s_barrier(); asm volatile("" ::: "memory");
#pragma unroll
        for (int bj = 0; bj < 2; ++bj) { const f32x4 g0 = *(const f32x4*)(g + col0 + bj * HALF), g1 = *(const f32x4*)(g + col0 + bj * HALF + 4);
#pragma unroll
            for (int ai = 0; ai < 2; ++ai)
#pragma unroll
                for (int m = 0; m < 4; ++m) { const int rl = ai * HALF + wr * 64 + m * 16 + fr; const float rs = tab[rl]; const size_t off = (size_t)(u.pm * BM + rl) * ldc + col0 + bj * HALF;
                    *(f32x4*)(out + off) = acc[ai][bj][m][0] * rs * g0; *(f32x4*)(out + off + 4) = acc[ai][bj][m][1] * rs * g1; } }
    }
};
struct EpiF32 : EpiBase {
    static constexpr bool PERM = false;
    float* out; int ldc; float scale;
    __device__ __forceinline__ void operator()(const f32x4 (&acc)[2][2][4][2], const Unit& u, int wr, int wc, int fr, int fq) const {
        const int col0 = u.pn * BM + wc * 32 + 4 * fq; float* base = out + zoff(u);
#pragma unroll
        for (int ai = 0; ai < 2; ++ai)
#pragma unroll
            for (int m = 0; m < 4; ++m) { const size_t off = (size_t)(u.pm * BM + ai * HALF + wr * 64 + m * 16 + fr) * ldc + col0;
#pragma unroll
                for (int bj = 0; bj < 2; ++bj)
#pragma unroll
                    for (int n = 0; n < 2; ++n) *(f32x4*)(base + off + bj * HALF + n * 16) = acc[ai][bj][m][n] * scale; }
    }
};
struct EpiSoftmax : EpiBase {
    static constexpr bool PERM = false;
    bf16_t* P; LAS float* red; const LAS float* rowss; int ldc; float scale;
    __device__ __forceinline__ void operator()(const f32x4 (&acc_)[2][2][4][2], const Unit& u, int wr, int wc, int fr_, int fq) const {
        int fr = fr_; asm volatile("" : "+v"(fr));
        f32x4 (&acc)[2][2][4][2] = const_cast<f32x4 (&)[2][2][4][2]>(acc_);
        const float sc0 = scale * 1.4426950408889634f; bf16_t* base = P + zoff(u);
        const int col0 = u.pn * BM + wc * 32 + 4 * fq;
#pragma unroll
        for (int ai = 0; ai < 2; ++ai)
#pragma unroll
            for (int m = 0; m < 4; ++m) { float mx = -INFINITY; const float sc = rowss ? sc0 * rowss[u.idx * 256 + ai * HALF + wr * 64 + m * 16 + fr] : sc0;
#pragma unroll
                for (int bj = 0; bj < 2; ++bj)
#pragma unroll
                    for (int n = 0; n < 2; ++n) { f32x4 v = acc[ai][bj][m][n] * sc; acc[ai][bj][m][n] = v; mx = fmaxf(mx, fmaxf(fmaxf(v[0], v[1]), fmaxf(v[2], v[3]))); }
                mx = fmaxf(mx, __shfl_xor(mx, 16)); mx = fmaxf(mx, __shfl_xor(mx, 32));
                if (fq == 0) red[(ai * HALF + wr * 64 + m * 16 + fr) * 4 + wc] = mx; }
        asm volatile("s_waitcnt lgkmcnt(0)" ::: "memory"); __builtin_amdgcn_s_barrier(); asm volatile("" ::: "memory");
#pragma unroll
        for (int ai = 0; ai < 2; ++ai)
#pragma unroll
            for (int m = 0; m < 4; ++m) { const int r = ai * HALF + wr * 64 + m * 16 + fr; const f32x4 pm4 = *(const LAS f32x4*)(red + r * 4);
                const float rm = fmaxf(fmaxf(pm4[0], pm4[1]), fmaxf(pm4[2], pm4[3])); float sm = 0.f;
#pragma unroll
                for (int bj = 0; bj < 2; ++bj)
#pragma unroll
                    for (int n = 0; n < 2; ++n) { f32x4 v = acc[ai][bj][m][n];
#pragma unroll
                        for (int j = 0; j < 4; ++j) { v[j] = __builtin_amdgcn_exp2f(v[j] - rm); sm += v[j]; }
                        acc[ai][bj][m][n] = v; }
                sm += __shfl_xor(sm, 16); sm += __shfl_xor(sm, 32);
                if (fq == 0) red[1024 + r * 4 + wc] = sm; }
        asm volatile("s_waitcnt lgkmcnt(0)" ::: "memory"); __builtin_amdgcn_s_barrier(); asm volatile("" ::: "memory");
#pragma unroll
        for (int ai = 0; ai < 2; ++ai)
#pragma unroll
            for (int m = 0; m < 4; ++m) { const int r = ai * HALF + wr * 64 + m * 16 + fr; const f32x4 ps = *(const LAS f32x4*)(red + 1024 + r * 4);
                const float inv = 1.0f / ((ps[0] + ps[1]) + (ps[2] + ps[3]));
                bf16_t* rowp = base + (size_t)(u.pm * BM + r) * ldc + col0;
#pragma unroll
                for (int bj = 0; bj < 2; ++bj)
#pragma unroll
                    for (int n = 0; n < 2; ++n) { const f32x4 v = acc[ai][bj][m][n] * inv; u32x2 w; w.x = cvt_pk_bf16(v[0], v[1]); w.y = cvt_pk_bf16(v[2], v[3]); *(u32x2*)(rowp + bj * HALF + n * 16) = w; } }
    }
};
struct EpiGate3 : EpiBase {
    static constexpr bool PERM = true, HOOK = true; static constexpr int H1 = 16, H2 = 24;
    const bf16_t* Zg; const float* bg; bf16_t* XN;
    __device__ __forceinline__ static void ld8(float (&x)[8], const bf16_t* zp, const float* bp) {
        const u32x4 gz = *(const u32x4*)zp; const f32x4 b0 = *(const f32x4*)bp, b1 = *(const f32x4*)(bp + 4);
        x[0] = bflo(gz.x) + b0[0]; x[1] = bfhi(gz.x) + b0[1]; x[2] = bflo(gz.y) + b0[2]; x[3] = bfhi(gz.y) + b0[3]; x[4] = bflo(gz.z) + b1[0]; x[5] = bfhi(gz.z) + b1[1]; x[6] = bflo(gz.w) + b1[2]; x[7] = bfhi(gz.w) + b1[3];
    }
    __device__ __forceinline__ void hook(f32x4 (&acc)[2][2][4][2], const Unit& u, int seg, int wr, int wc, int fr_, int fq) const {
        int fr = fr_; asm volatile("" : "+v"(fr));
        const int col0 = u.pn * BM + wc * 32 + 8 * fq;
#pragma unroll
        for (int ai = 0; ai < 2; ++ai)
#pragma unroll
            for (int m = 0; m < 4; ++m) { const size_t row = (size_t)(u.pm * BM + ai * HALF + wr * 64 + m * 16 + fr);
#pragma unroll
                for (int bj = 0; bj < 2; ++bj) { const int col = col0 + bj * HALF; float xa[8], xb[8];
                    ld8(xa, Zg + row * ZP + seg * D_ + col, bg + seg * D_ + col); ld8(xb, Zg + row * ZP + (seg + 1) * D_ + col, bg + (seg + 1) * D_ + col);
#pragma unroll
                    for (int j = 0; j < 8; ++j) { const float ea = __builtin_amdgcn_exp2f(-1.4426950408889634f * xa[j]), eb = __builtin_amdgcn_exp2f(-1.4426950408889634f * xb[j]);
                        acc[ai][bj][m][j >> 2][j & 3] *= (1.0f + eb) * __builtin_amdgcn_rcpf(1.0f + ea); } } }
    }
    __device__ __forceinline__ void operator()(const f32x4 (&acc)[2][2][4][2], const Unit& u, int wr, int wc, int fr, int fq) const {
        const int col0 = u.pn * BM + wc * 32 + 8 * fq;
#pragma unroll
        for (int ai = 0; ai < 2; ++ai)
#pragma unroll
            for (int m = 0; m < 4; ++m) { const size_t row = (size_t)(u.pm * BM + ai * HALF + wr * 64 + m * 16 + fr);
#pragma unroll
                for (int bj = 0; bj < 2; ++bj) { const int col = col0 + bj * HALF; float x[8], v[8];
                    ld8(x, Zg + row * ZP + 2 * D_ + col, bg + 2 * D_ + col);
#pragma unroll
                    for (int j = 0; j < 8; ++j) v[j] = acc[ai][bj][m][j >> 2][j & 3] * sigm(x[j]);
                    u32x4 w; w.x = cvt_pk_bf16(v[0], v[1]); w.y = cvt_pk_bf16(v[2], v[3]); w.z = cvt_pk_bf16(v[4], v[5]); w.w = cvt_pk_bf16(v[6], v[7]);
                    *(u32x4*)(XN + row * D_ + col) = w; } }
    }
};
struct EpiGate : EpiBase {
    static constexpr bool PERM = true;
    const bf16_t* Zg; const float* bg; float* MG; bf16_t* XN; int mode;
    __device__ __forceinline__ void operator()(const f32x4 (&acc)[2][2][4][2], const Unit& u, int wr, int wc, int fr, int fq) const {
        const int col0 = u.pn * BM + wc * 32 + 8 * fq;
#pragma unroll
        for (int ai = 0; ai < 2; ++ai)
#pragma unroll
            for (int m = 0; m < 4; ++m) { const size_t row = (size_t)(u.pm * BM + ai * HALF + wr * 64 + m * 16 + fr);
#pragma unroll
                for (int bj = 0; bj < 2; ++bj) { const int col = col0 + bj * HALF;
                    const u32x4 gz = *(const u32x4*)(Zg + row * ZP + col); const f32x4 bb0 = *(const f32x4*)(bg + col), bb1 = *(const f32x4*)(bg + col + 4);
                    float gp[8] = {bflo(gz.x) + bb0[0], bfhi(gz.x) + bb0[1], bflo(gz.y) + bb0[2], bfhi(gz.y) + bb0[3], bflo(gz.z) + bb1[0], bfhi(gz.z) + bb1[1], bflo(gz.w) + bb1[2], bfhi(gz.w) + bb1[3]};
                    float v[8];
#pragma unroll
                    for (int j = 0; j < 8; ++j) v[j] = acc[ai][bj][m][j >> 2][j & 3] * pg8::sigm(gp[j]);
                    u32x4* mp = (u32x4*)(XN + row * D_ + col);
                    if (mode != 0) { const u32x4 o = *mp; v[0] += bflo(o.x); v[1] += bfhi(o.x); v[2] += bflo(o.y); v[3] += bfhi(o.y); v[4] += bflo(o.z); v[5] += bfhi(o.z); v[6] += bflo(o.w); v[7] += bfhi(o.w); }
                    u32x4 w; w.x = cvt_pk_bf16(v[0], v[1]); w.y = cvt_pk_bf16(v[2], v[3]); w.z = cvt_pk_bf16(v[4], v[5]); w.w = cvt_pk_bf16(v[6], v[7]); *mp = w; }
                }
    }
};

template <class Epi>
__device__ __forceinline__ void gemm_phase(LAS unsigned char* lds, const Gemm g, const StaticOrder& S, const Epi& E) {
    const int tid = tid_opaque(), wid = __builtin_amdgcn_readfirstlane(tid >> 6), lane = tid & 63, wr = wid >> 2, wc = wid & 3, fr = lane & 15, fq = lane >> 4;
    const int K = g.K, nt = K / BK;
    unsigned voffA[2], voffB[2];
#pragma unroll
    for (int i = 0; i < 2; ++i) { int R, C; stage_rc(tid * 16 + i * 8192, R, C); const int Rb = Epi::PERM ? ((R & ~31) + perm32(R & 31)) : R;
        voffA[i] = (unsigned)(R * g.lda + C) * 2u; voffB[i] = (unsigned)(Rb * g.ldb + C) * 2u; }
    const size_t kstep = (size_t)(BK * 2);
    const size_t hstepA = (size_t)HALF * g.lda * 2, hstepB = (size_t)HALF * g.ldb * 2;
    const size_t tstepA = 2 * hstepA, tstepB = 2 * hstepB;
    const unsigned ldsw = (unsigned)wid * 1024u;
    const int aoff = lds_byte(wr * 64 + fr, fq * 8), boff = lds_byte(wc * 32 + fr, fq * 8);
#define PG8_SA(b, h) (((b) * 2 + (h)) * HTB)
#define PG8_SB(b, h) ((4 + (b) * 2 + (h)) * HTB)
#define PG8_STAGE(bufoff, gbase, voff) do { _Pragma("unroll") for (int _i = 0; _i < 2; ++_i) \
        __builtin_amdgcn_global_load_lds((const unsigned*)((const char*)(gbase) + (voff)[_i]), (LAS unsigned*)(lds + (bufoff) + ldsw + _i * 8192), 16, 0, 0); } while (0)
#define PG8_LDA(dst, b, h) do { _Pragma("unroll") for (int m = 0; m < 4; ++m) _Pragma("unroll") for (int k = 0; k < 2; ++k) dst[m][k] = *(const LAS bf16x8*)(lds + PG8_SA(b, h) + aoff + m * 2048 + k * 1024); } while (0)
#define PG8_LDB(dst, b, h) do { _Pragma("unroll") for (int n = 0; n < 2; ++n) _Pragma("unroll") for (int k = 0; k < 2; ++k) dst[n][k] = *(const LAS bf16x8*)(lds + PG8_SB(b, h) + boff + n * 2048 + k * 1024); } while (0)
#define PG8_MMA(ai, bj, At, Bt) do { __builtin_amdgcn_s_setprio(1); _Pragma("unroll") for (int m = 0; m < 4; ++m) _Pragma("unroll") for (int n = 0; n < 2; ++n) _Pragma("unroll") for (int k = 0; k < 2; ++k) \
        acc[ai][bj][m][n] = __builtin_amdgcn_mfma_f32_16x16x32_bf16(Bt[n][k], At[m][k], acc[ai][bj][m][n], 0, 0, 0); __builtin_amdgcn_s_setprio(0); } while (0)
#define PG8_WAIT_V(n) asm volatile("s_waitcnt vmcnt(" #n ")" ::: "memory")
#define PG8_WAIT_L(n) asm volatile("s_waitcnt lgkmcnt(" #n ")" ::: "memory")
#define PG8_BAR __builtin_amdgcn_s_barrier()
#define PG8_SCHED __builtin_amdgcn_sched_barrier(0)
    PG8_WAIT_V(0); PG8_WAIT_L(0); PG8_BAR;
    Unit cur, nxt; int ui = 0;
    if (!S.next(0, cur)) return;
    f32x4 acc[2][2][4][2];
#pragma unroll
    for (int a = 0; a < 2; ++a)
#pragma unroll
        for (int b = 0; b < 2; ++b)
#pragma unroll
            for (int m = 0; m < 4; ++m)
#pragma unroll
                for (int n = 0; n < 2; ++n) acc[a][b][m][n] = (f32x4){0.f, 0.f, 0.f, 0.f};
    bf16x8 At[4][2], B0[2][2], B1[2][2];
    const bf16_t* gA1 = g.A1; const bf16_t* gB1 = g.B1; const bf16_t* gA2 = g.A2; const bf16_t* gB2 = g.B2;
    asm volatile("" : "+s"(gA1), "+s"(gB1), "+s"(gA2), "+s"(gB2));
#define PG8_PA(u) ((const char*)((u).grp == 0 ? g.A + (long)((u).z / g.nzh) * g.sAb + (long)((u).z % g.nzh) * g.sAh : ((u).grp == 1 ? gA1 : gA2)) + (size_t)(u).pm * tstepA)
#define PG8_PB(u) ((const char*)((u).grp == 0 ? g.Bt + (long)((u).z / g.nzh) * g.sBb + (long)((u).z % g.nzh) * g.sBh : ((u).grp == 1 ? gB1 : gB2)) + (size_t)(u).pn * tstepB)
    const char* cA = PG8_PA(cur);
    const char* cB = PG8_PB(cur);
    PG8_STAGE(PG8_SB(0, 0), cB, voffB); PG8_STAGE(PG8_SB(0, 1), cB + hstepB, voffB); PG8_STAGE(PG8_SA(0, 0), cA, voffA); PG8_STAGE(PG8_SA(0, 1), cA + hstepA, voffA);
    if (wr == 1) PG8_BAR;
    PG8_WAIT_V(2); PG8_BAR;
    PG8_STAGE(PG8_SB(1, 0), cB + kstep, voffB); PG8_STAGE(PG8_SA(1, 0), cA + kstep, voffA); PG8_STAGE(PG8_SB(1, 1), cB + hstepB + kstep, voffB);
    PG8_WAIT_V(6); PG8_BAR;
    for (;;) {
        const bool has_next = S.next(ui + 1, nxt);
        const char* nA = has_next ? PG8_PA(nxt) : cA;
        const char* nB = has_next ? PG8_PB(nxt) : cB;
        for (int t = 0; t < nt; t += 2) {
            if constexpr (Epi::HOOK) { if (t == Epi::H1 || t == Epi::H2) E.hook(acc, cur, t == Epi::H1 ? 0 : 1, wr, wc, fr, fq); }
            const bool last = (t == nt - 2);
            const char* a1 = cA + (size_t)(t + 1) * kstep;
            const char* a2 = last ? nA : cA + (size_t)(t + 2) * kstep; const char* b2 = last ? nB : cB + (size_t)(t + 2) * kstep;
            const char* a3 = a2 + kstep; const char* b3 = b2 + kstep;
            PG8_LDB(B0, 0, 0); PG8_LDB(B1, 0, 1); PG8_SCHED; PG8_LDA(At, 0, 0); PG8_STAGE(PG8_SA(1, 1), a1 + hstepA, voffA);
            PG8_WAIT_V(8); PG8_WAIT_L(0); PG8_BAR; PG8_MMA(0, 0, At, B0); PG8_MMA(0, 1, At, B1); PG8_BAR; PG8_SCHED;
            PG8_LDA(At, 0, 1); PG8_STAGE(PG8_SB(0, 0), b2, voffB); PG8_STAGE(PG8_SB(0, 1), b2 + hstepB, voffB); PG8_STAGE(PG8_SA(0, 0), a2, voffA);
            PG8_WAIT_V(8); PG8_WAIT_L(0); PG8_BAR; PG8_MMA(1, 0, At, B0); PG8_MMA(1, 1, At, B1); PG8_BAR; PG8_SCHED;
            PG8_LDB(B0, 1, 0); PG8_LDB(B1, 1, 1); PG8_SCHED; PG8_LDA(At, 1, 0); PG8_STAGE(PG8_SA(0, 1), a2 + hstepA, voffA);
            PG8_WAIT_V(8); PG8_WAIT_L(0); PG8_BAR; PG8_MMA(0, 0, At, B0); PG8_MMA(0, 1, At, B1); PG8_BAR; PG8_SCHED;
            PG8_LDA(At, 1, 1); PG8_STAGE(PG8_SB(1, 0), b3, voffB); PG8_STAGE(PG8_SB(1, 1), b3 + hstepB, voffB); PG8_STAGE(PG8_SA(1, 0), a3, voffA);
            PG8_WAIT_V(8); PG8_WAIT_L(0); PG8_BAR; PG8_MMA(1, 0, At, B0); PG8_MMA(1, 1, At, B1); PG8_BAR; PG8_SCHED;
        }
        if (wr == 0) PG8_BAR;
        E(acc, cur, wr, wc, fr, fq);
        if (!has_next) break;
#pragma unroll
        for (int a = 0; a < 2; ++a)
#pragma unroll
            for (int b = 0; b < 2; ++b)
#pragma unroll
                for (int m = 0; m < 4; ++m)
#pragma unroll
                    for (int n = 0; n < 2; ++n) acc[a][b][m][n] = (f32x4){0.f, 0.f, 0.f, 0.f};
        cur = nxt; cA = nA; cB = nB; ++ui;
        if (wr == 1) PG8_BAR;
    }
    PG8_WAIT_V(0);
    PG8_BAR;
#undef PG8_PA
#undef PG8_PB
#undef PG8_SA
#undef PG8_SB
#undef PG8_STAGE
#undef PG8_LDA
#undef PG8_LDB
#undef PG8_MMA
#undef PG8_WAIT_V
#undef PG8_WAIT_L
#undef PG8_BAR
#undef PG8_SCHED
}
}

#define XB_TMO      128
#define XB_XCNT(j)  (256  + 64 * (j))
#define XB_XSUB(j)  (1280 + 64 * (j))
#define XB_XGEN(j)  (2304 + 64 * (j))
#define XB_TOP      3328
#define XB_TOPGEN   3392
#define XCD_BAR_WORDS 3456
#define XB_SPIN_CAP (1u << 18)
__device__ __forceinline__ unsigned xb_ld(unsigned* p)              { return __hip_atomic_load(p, __ATOMIC_RELAXED, __HIP_MEMORY_SCOPE_AGENT); }
__device__ __forceinline__ unsigned xb_add(unsigned* p, unsigned v) { return __hip_atomic_fetch_add(p, v, __ATOMIC_RELAXED, __HIP_MEMORY_SCOPE_AGENT); }
__device__ __forceinline__ unsigned xb_xcc_id() { return (unsigned)__builtin_amdgcn_s_getreg((3 << 11) | 20) & 0xFu; }
#define XB_SPIN(cond, bar) do { unsigned _sp = 0; while (cond) { __builtin_amdgcn_s_sleep(1); \
    if ((++_sp & 255u) == 0u) { if (xb_ld(&(bar)[XB_TMO])) break; if (_sp > XB_SPIN_CAP) { atomicAdd(&(bar)[XB_TMO], 1u); break; } } } } while (0)
struct XcdBarrier { unsigned* bar; unsigned x; volatile LAS unsigned* st; };
__device__ __forceinline__ XcdBarrier xcd_barrier_post(unsigned* bar, volatile LAS unsigned* st) {
    XcdBarrier b; b.bar = bar; b.x = xb_xcc_id(); b.st = st;
    if (threadIdx.x == 0) (void)xb_add(&bar[XB_XCNT(b.x)], 1u);
    return b;
}
__device__ __forceinline__ void xcd_barrier_complete(unsigned* bar, unsigned x, unsigned& nloc, unsigned& nx) {
    const unsigned G = gridDim.x * gridDim.y * gridDim.z;
    unsigned sum, cnt, mine, sp = 0u;
    for (;;) {
        sum = 0u; cnt = 0u; mine = 0u;
#pragma unroll
        for (unsigned j = 0; j < 16; ++j) { const unsigned c = xb_ld(&bar[XB_XCNT(j)]); sum += c; cnt += (c > 0u) ? 1u : 0u; mine = (j == x) ? c : mine; }
        if (sum == G) break;
        __builtin_amdgcn_s_sleep(1);
        if ((++sp & 255u) == 0u) { if (xb_ld(&bar[XB_TMO])) break; if (sp > XB_SPIN_CAP) { atomicAdd(&bar[XB_TMO], 1u); break; } }
    }
    nloc = mine > 0u ? mine : 1u; nx = cnt > 0u ? cnt : 1u;
}
__device__ __forceinline__ void xcd_barrier(const XcdBarrier& b) {
    asm volatile("s_waitcnt vmcnt(0)" ::: "memory");
    __syncthreads();
    if (threadIdx.x == 0) {
        unsigned* bar = b.bar;
        __builtin_amdgcn_s_waitcnt(0);
        unsigned nloc = b.st[0], nx = b.st[1];
        if (nloc == 0u) { xcd_barrier_complete(bar, b.x, nloc, nx); b.st[0] = nloc; b.st[1] = nx; }
        const unsigned old = xb_add(&bar[XB_XSUB(b.x)], 1u);
        const unsigned gen = old / nloc;
        if (old + 1u == (gen + 1u) * nloc) {
            __builtin_amdgcn_fence(__ATOMIC_RELEASE, "agent");
            asm volatile("s_waitcnt vmcnt(0)" ::: "memory");
            const unsigned og = xb_add(&bar[XB_TOP], 1u);
            const unsigned tg = og / nx;
            if (og + 1u == (tg + 1u) * nx) xb_add(&bar[XB_TOPGEN], 1u);
            else XB_SPIN(xb_ld(&bar[XB_TOPGEN]) == tg, bar);
            __builtin_amdgcn_fence(__ATOMIC_ACQUIRE, "agent");
            xb_add(&bar[XB_XGEN(b.x)], 1u);
            asm volatile("s_waitcnt vmcnt(0)" ::: "memory");
        } else {
            XB_SPIN(xb_ld(&bar[XB_XGEN(b.x)]) == gen, bar);
            __builtin_amdgcn_fence(__ATOMIC_ACQUIRE, "agent");
            asm volatile("s_waitcnt vmcnt(0)" ::: "memory");
        }
    }
    __syncthreads();
}

struct Args { const float* in[29]; float* out; unsigned char* ws; int lo, hi; };
enum { I_X = 0, I_MEM, I_F1N, I_F1I, I_F1O, I_MIXN, I_WIN, I_BGATE, I_QN, I_KVN, I_WUQ, I_WUKV, I_WPM, I_WA2, I_BA, I_GLAN, I_WPG, I_CONVW, I_WPC, I_WMO,
       I_XN, I_MEMN, I_WXQ, I_WXKV, I_WXO, I_F2N, I_F2I, I_F2O, I_FINN };

__device__ __forceinline__ void transpose_job(const float* W, int ldw, int c0, int ncols, int ncpad, int K, bf16_t* WT, int ldk, int koff, int mode, int p0, const float* gk,
                                              LAS float* scr, int gw, int NGW, int lane) {
    const int nblk = ncpad / 32, items = (K / 64) * nblk;
    for (int item = gw; item < items; item += NGW) {
        const int kb = item / nblk, nb = item % nblk, k0 = 64 * kb, n0 = 32 * nb;
        int r0;
        if (mode == 0) r0 = n0;
        else if (mode == 1) { const int half = n0 >= F_ ? 1 : 0; const int n1 = n0 - half * F_; r0 = 256 * (n1 / 128) + half * 128 + (n1 % 128); }
        else { const int grp = n0 / 256, within = n0 % 256; r0 = (within / 128 == p0) ? grp * 128 + (within % 128) : -1; }
        if (r0 < 0) continue;
        const int nn = n0 + (lane & 31); const bool ok = nn < ncols;
        float tv[32];
        const float* wp = W + (size_t)(k0 + (lane >> 5)) * ldw + c0 + (ok ? nn : 0);
#pragma unroll
        for (int i = 0; i < 32; ++i) tv[i] = wp[(size_t)(2 * i) * ldw];
#pragma unroll
        for (int i = 0; i < 32; ++i) { const int kk = 2 * i + (lane >> 5); scr[kk * 33 + (lane & 31)] = ok ? tv[i] : 0.f; }
        asm volatile("s_waitcnt lgkmcnt(0)" ::: "memory");
        const int c = lane & 7;
        f32x4 ga = (f32x4){1.f, 1.f, 1.f, 1.f}, gb = ga;
        if (gk) { ga = *(const f32x4*)(gk + k0 + 8 * c); gb = *(const f32x4*)(gk + k0 + 8 * c + 4); }
#pragma unroll
        for (int j = 0; j < 4; ++j) { const int n = (lane >> 3) + 8 * j; const LAS float* s = scr + (8 * c) * 33 + n;
            u32x4 o; o.x = cvt_pk_bf16(s[0 * 33] * ga[0], s[1 * 33] * ga[1]); o.y = cvt_pk_bf16(s[2 * 33] * ga[2], s[3 * 33] * ga[3]); o.z = cvt_pk_bf16(s[4 * 33] * gb[0], s[5 * 33] * gb[1]); o.w = cvt_pk_bf16(s[6 * 33] * gb[2], s[7 * 33] * gb[3]);
            *(u32x4*)(WT + (size_t)(r0 + n) * ldk + koff + k0 + 8 * c) = o; }
        asm volatile("s_waitcnt lgkmcnt(0)" ::: "memory");
    }
}

__device__ __forceinline__ void convert_job(const Args& a, int l, int j, LAS float* scr, int gw, int NGW, int lane) {
    unsigned char* ws = a.ws;
                const float* W; const float* gk = nullptr; int ldw, c0 = 0, ncols, ncpad, K, mode = 0, p0 = 0, ldk = 0, koff = 0; size_t dst;
                switch (j) {
                case 0: W = a.in[I_F1I] + (size_t)l * D_ * 2 * F_; ldw = 2 * F_; ncols = 2 * F_; K = D_; dst = WS_W1I; mode = 1; gk = a.in[I_F1N] + l * D_; break;
                case 1: W = a.in[I_F1O] + (size_t)l * F_ * D_; ldw = D_; ncols = D_; K = F_; dst = WS_W1O; break;
                case 2: W = a.in[I_WIN] + (size_t)l * D_ * NZIN; ldw = NZIN; ncols = NZIN; K = D_; dst = WS_WIN; gk = a.in[I_MIXN] + l * D_; break;
                case 3: W = a.in[I_WUQ] + (size_t)l * 512 * 1536; ldw = 1536; ncols = 1536; K = 512; dst = WS_WUQ; break;
                case 4: W = a.in[I_WUKV] + (size_t)l * 512 * 2048; ldw = 2048; ncols = 2048; K = 512; dst = WS_WUK; mode = 2; p0 = 0; break;
                case 5: W = a.in[I_WUKV] + (size_t)l * 512 * 2048; ldw = 2048; ncols = 2048; K = 512; dst = WS_WUV; mode = 2; p0 = 1; break;
                case 6: W = a.in[I_WPM] + (size_t)l * 1024 * 2048; ldw = 2048; ncols = 2048; K = 1024; dst = WS_WPM; ldk = 2048; koff = 0; break;
                case 7: W = a.in[I_WPG] + (size_t)l * 512 * 2048; ldw = 2048; ncols = 2048; K = 512; dst = WS_WPM; ldk = 2048; koff = 1024; break;
                case 8: W = a.in[I_WPC] + (size_t)l * 512 * 2048; ldw = 2048; ncols = 2048; K = 512; dst = WS_WPM; ldk = 2048; koff = 1536; break;
                case 9: W = a.in[I_WMO] + (size_t)l * 2048 * 2048; ldw = 2048; ncols = 2048; K = 2048; dst = WS_WMO; break;
                case 10: {
                    const float* Wq = a.in[I_WXQ] + (size_t)l * 2048 * 2048; const float* gq = a.in[I_XN] + l * D_; bf16_t* dq = (bf16_t*)(ws + WS_WXQ);
                    for (int c8 = gw * 64 + lane; c8 < 2048 * 256; c8 += NGW * 64) { const int row = c8 >> 8; const float gg = gq[row];
                        const f32x4 x0 = *(const f32x4*)(Wq + (size_t)c8 * 8), x1 = *(const f32x4*)(Wq + (size_t)c8 * 8 + 4);
                        u32x4 o; o.x = cvt_pk_bf16(x0[0] * gg, x0[1] * gg); o.y = cvt_pk_bf16(x0[2] * gg, x0[3] * gg); o.z = cvt_pk_bf16(x1[0] * gg, x1[1] * gg); o.w = cvt_pk_bf16(x1[2] * gg, x1[3] * gg);
                        *(u32x4*)(dq + (size_t)c8 * 8) = o; }
                    return; }
                case 11: W = a.in[I_WXKV] + (size_t)l * 2048 * 4096; ldw = 4096; ncols = 2048; K = 2048; dst = WS_WXK; break;
                case 12: W = a.in[I_WXKV] + (size_t)l * 2048 * 4096; ldw = 4096; c0 = 2048; ncols = 2048; K = 2048; dst = WS_WXV; break;
                case 13: W = a.in[I_WXO] + (size_t)l * 2048 * 2048; ldw = 2048; ncols = 2048; K = 2048; dst = WS_WXO; break;
                case 14: W = a.in[I_F2I] + (size_t)l * D_ * 2 * F_; ldw = 2 * F_; ncols = 2 * F_; K = D_; dst = WS_W2I; mode = 1; gk = a.in[I_F2N] + l * D_; break;
                default: W = a.in[I_F2O] + (size_t)l * F_ * D_; ldw = D_; ncols = D_; K = F_; dst = WS_W2O; break;
                }
                ncpad = (j == 2) ? ZP : ncols;
                transpose_job(W, ldw, c0, ncols, ncpad, K, (bf16_t*)(ws + dst), ldk ? ldk : K, koff, mode, p0, gk, scr, gw, NGW, lane);
            }
__device__ __forceinline__ void rms_row_bf16(const float* xrow, const float* g, bf16_t* orow, int lane) {
    const f32x4* xr = (const f32x4*)xrow + lane; const f32x4* gr = (const f32x4*)g + lane;
    f32x4 v[8]; float s = 0.f;
#pragma unroll
    for (int j = 0; j < 8; ++j) { v[j] = xr[64 * j]; s += (v[j][0] * v[j][0] + v[j][1] * v[j][1]) + (v[j][2] * v[j][2] + v[j][3] * v[j][3]); }
    const float rstd = 1.0f / sqrtf(wave_sum(s) * (1.0f / 2048.0f) + EPS_);
    u32x2* o8 = (u32x2*)orow + lane;
#pragma unroll
    for (int j = 0; j < 8; ++j) { const f32x4 gg = gr[64 * j]; u32x2 w; w.x = cvt_pk_bf16(v[j][0] * rstd * gg[0], v[j][1] * rstd * gg[1]); w.y = cvt_pk_bf16(v[j][2] * rstd * gg[2], v[j][3] * rstd * gg[3]); o8[64 * j] = w; }
}
__device__ __forceinline__ void rms_row_f32(float* xrow, const float* g, int lane) {
    f32x4* xr = (f32x4*)xrow + lane; const f32x4* gr = (const f32x4*)g + lane;
    f32x4 v[8]; float s = 0.f;
#pragma unroll
    for (int j = 0; j < 8; ++j) { v[j] = xr[64 * j]; s += (v[j][0] * v[j][0] + v[j][1] * v[j][1]) + (v[j][2] * v[j][2] + v[j][3] * v[j][3]); }
    const float rstd = 1.0f / sqrtf(wave_sum(s) * (1.0f / 2048.0f) + EPS_);
#pragma unroll
    for (int j = 0; j < 8; ++j) { const f32x4 gg = gr[64 * j]; xr[64 * j] = v[j] * rstd * gg; }
}

__device__ __forceinline__ void mixer_row(const Args& a, int l, int t, int lane) {
    unsigned char* ws = a.ws;
    const bf16_t* Z = (const bf16_t*)(ws + WS_Z); const bf16_t* zr = Z + (size_t)t * ZP;
#pragma unroll
    for (int which = 0; which < 2; ++which) {
        const u32x4 w = *(const u32x4*)(zr + (which ? OFF_CKV : OFF_CQ) + lane * 8);
        float x[8] = {bflo(w.x), bfhi(w.x), bflo(w.y), bfhi(w.y), bflo(w.z), bfhi(w.z), bflo(w.w), bfhi(w.w)};
        float s = 0.f;
#pragma unroll
        for (int j = 0; j < 8; ++j) s += x[j] * x[j];
        const float rstd = 1.0f / sqrtf(wave_sum(s) * (1.0f / 512.0f) + EPS_);
        const float* g = a.in[which ? I_KVN : I_QN] + l * 512 + lane * 8;
        u32x4 o; o.x = cvt_pk_bf16(x[0] * rstd * g[0], x[1] * rstd * g[1]); o.y = cvt_pk_bf16(x[2] * rstd * g[2], x[3] * rstd * g[3]);
        o.z = cvt_pk_bf16(x[4] * rstd * g[4], x[5] * rstd * g[5]); o.w = cvt_pk_bf16(x[6] * rstd * g[6], x[7] * rstd * g[7]);
        *(u32x4*)((bf16_t*)(ws + (which ? WS_CKVN : WS_CQN)) + (size_t)t * 512 + lane * 8) = o;
    }
    {
        const int i = lane & 31, pos = t & (S_ - 1);
        const float x1 = bf2f(zr[OFF_KR + i]), x2 = bf2f(zr[OFF_KR + 32 + i]);
        const f32x2 cs = ((const f32x2*)(ws + WS_CS))[pos * 32 + i];
        const float o = (lane < 32) ? (x1 * cs.x - x2 * cs.y) : (x2 * cs.x + x1 * cs.y);
        ((bf16_t*)(ws + WS_KPE))[(size_t)t * 64 + lane] = (bf16_t)(cvt_pk_bf16(o, 0.f) & 0xffffu);
    }
    {
        const int pos = t & (S_ - 1); const int c = lane * 8;
        const float* cw = a.in[I_CONVW] + l * 1536 + c;
        float accv[8] = {0.f, 0.f, 0.f, 0.f, 0.f, 0.f, 0.f, 0.f};
#pragma unroll
        for (int w = 0; w < 3; ++w) {
            const int dt = 2 - w;
            if (pos - dt >= 0) {
                const bf16_t* zz = zr - (size_t)dt * ZP + OFF_CV;
                const u32x4 cg_ = *(const u32x4*)(zz + 512 + c), hh = *(const u32x4*)(zz + 1024 + c);
                const float cgv[8] = {bflo(cg_.x), bfhi(cg_.x), bflo(cg_.y), bfhi(cg_.y), bflo(cg_.z), bfhi(cg_.z), bflo(cg_.w), bfhi(cg_.w)};
                const float hv[8] = {bflo(hh.x), bfhi(hh.x), bflo(hh.y), bfhi(hh.y), bflo(hh.z), bfhi(hh.z), bflo(hh.w), bfhi(hh.w)};
#pragma unroll
                for (int j = 0; j < 8; ++j) accv[j] += cw[w * 512 + j] * (cgv[j] * hv[j]);
            }
        }
        const u32x4 bgw = *(const u32x4*)(zr + OFF_CV + c);
        const float bv[8] = {bflo(bgw.x), bfhi(bgw.x), bflo(bgw.y), bfhi(bgw.y), bflo(bgw.z), bfhi(bgw.z), bflo(bgw.w), bfhi(bgw.w)};
        u32x4 o; o.x = cvt_pk_bf16(bv[0] * accv[0], bv[1] * accv[1]); o.y = cvt_pk_bf16(bv[2] * accv[2], bv[3] * accv[3]);
        o.z = cvt_pk_bf16(bv[4] * accv[4], bv[5] * accv[5]); o.w = cvt_pk_bf16(bv[6] * accv[6], bv[7] * accv[7]);
        *(u32x4*)((bf16_t*)(ws + WS_ACT) + (size_t)t * 2048 + 1536 + c) = o;
    }
}

template <int NC>
__device__ __forceinline__ void lds_mm(float (&acc)[4][NC], const LAS float* Ap, int sAr, int sAk, const LAS float* Bp, int sBk, int sBc, int ty, int tx) {
    f32x2 acc2[4][NC / 2];
#pragma unroll
    for (int i = 0; i < 4; ++i)
#pragma unroll
        for (int j = 0; j < NC / 2; ++j) acc2[i][j] = (f32x2){0.f, 0.f};
#pragma unroll 8
    for (int k = 0; k < 64; ++k) {
        float av[4]; f32x2 bv[NC / 2];
#pragma unroll
        for (int i = 0; i < 4; ++i) av[i] = Ap[(4 * ty + i) * sAr + k * sAk];
#pragma unroll
        for (int j = 0; j < NC / 2; ++j) { bv[j].x = Bp[k * sBk + (tx + 64 * j) * sBc]; bv[j].y = Bp[k * sBk + (tx + 64 * j + 32) * sBc]; }
#pragma unroll
        for (int i = 0; i < 4; ++i)
#pragma unroll
            for (int j = 0; j < NC / 2; ++j) acc2[i][j] += bv[j] * av[i];
    }
#pragma unroll
    for (int i = 0; i < 4; ++i)
#pragma unroll
        for (int j = 0; j < NC / 2; ++j) { acc[i][2 * j] = acc2[i][j].x; acc[i][2 * j + 1] = acc2[i][j].y; }
}
__device__ __forceinline__ f32x16 lds_mm32(const LAS float* Ap, int sAr, int sAk, const LAS float* Bp, int sBk, int sBc, int rb, int cb, int r32, int hi) {
    f32x16 c;
#pragma unroll
    for (int r = 0; r < 16; ++r) c[r] = 0.f;
    const LAS float* ap = Ap + (rb * 32 + r32) * sAr + hi * sAk; const LAS float* bp = Bp + hi * sBk + (cb * 32 + r32) * sBc;
#pragma unroll 8
    for (int st = 0; st < 32; ++st) c = __builtin_amdgcn_mfma_f32_32x32x2f32(ap[2 * st * sAk], bp[2 * st * sBk], c, 0, 0, 0);
    return c;
}
__device__ __forceinline__ int grow(int r, int hi) { return (r & 3) + 8 * (r >> 2) + 4 * hi; }
constexpr int GP = 65;
__device__ __forceinline__ void gla_p1(const Args& a, int l, int unit, LAS float* L) {
    unsigned char* ws = a.ws; const int tid = tid_opaque();
    const int n = unit & 63, h = (unit >> 6) & 3, b = unit >> 8;
    const int t0 = b * S_ + n * 64;
    const bf16_t* Z = (const bf16_t*)(ws + WS_Z);
    LAS float* qs = L; LAS float* ks = qs + 64 * GP; LAS float* kd = ks + 64 * GP; LAS float* bc = kd + 64 * GP; LAS float* Am = bc + 64 * GP;
    LAS float* vs = Am + 64 * GP; LAS float* al = vs + 64 * 128;
    __syncthreads();
    {
        const int t = tid >> 3, part = tid & 7; const bf16_t* zr = Z + (size_t)(t0 + t) * ZP;
        const u32x4 wq = *(const u32x4*)(zr + OFF_GQ + h * 64 + part * 8), wk = *(const u32x4*)(zr + OFF_GK + h * 64 + part * 8);
        const u32x4 wv0 = *(const u32x4*)(zr + OFF_GV + h * 128 + part * 8), wv1 = *(const u32x4*)(zr + OFF_GV + h * 128 + 64 + part * 8);
        u32x4 wa = (u32x4){0u, 0u, 0u, 0u}; if (part < 2) wa = *(const u32x4*)(zr + OFF_AL + part * 8);
#define GLA_UNPK(dst, VV) do { (dst)[0] = bflo((VV).x); (dst)[1] = bfhi((VV).x); (dst)[2] = bflo((VV).y); (dst)[3] = bfhi((VV).y); (dst)[4] = bflo((VV).z); (dst)[5] = bfhi((VV).z); (dst)[6] = bflo((VV).w); (dst)[7] = bfhi((VV).w); } while (0)
        LAS float* q_ = qs + t * GP + part * 8; LAS float* k_ = ks + t * GP + part * 8; LAS float* v0_ = vs + t * 128 + part * 8; LAS float* v1_ = v0_ + 64;
        GLA_UNPK(q_, wq); GLA_UNPK(k_, wk); GLA_UNPK(v0_, wv0); GLA_UNPK(v1_, wv1);
        if (part < 2) { LAS float* a_ = al + t * 16 + part * 8; GLA_UNPK(a_, wa); }
#undef GLA_UNPK
    }
    __syncthreads();
    {
        const int j = tid & 63, tg = tid >> 6;
        const float* w2 = a.in[I_WA2] + l * 4096 + h * 64 + j; float w[16];
#pragma unroll
        for (int i = 0; i < 16; ++i) w[i] = w2[i * 256];
        const float bias = a.in[I_BA][l * 256 + h * 64 + j];
#pragma unroll
        for (int tt = 0; tt < 8; ++tt) { const int t = tg * 8 + tt; float x = bias;
#pragma unroll
            for (int i = 0; i < 16; ++i) x += al[t * 16 + i] * w[i];
            bc[t * GP + j] = (fminf(x, 0.f) - log1pf(__expf(-fabsf(x)))) * (1.0f / 16.0f); }
    }
    __syncthreads();
    if (tid < 64) { float run = 0.f;
#pragma unroll 8
        for (int t = 0; t < 64; ++t) { run += bc[t * GP + tid]; bc[t * GP + tid] = run; } }
    __syncthreads();
    float* QD = (float*)(ws + WS_QD);
    for (int e = tid; e < 64 * 64; e += NTHR) { const int t = e >> 6, d = e & 63; const float bb = bc[t * GP + d], bl = bc[63 * GP + d];
        const float q = qs[t * GP + d] * 0.125f * __expf(bb), k = ks[t * GP + d];
        qs[t * GP + d] = q; QD[(size_t)(t0 + t) * 256 + h * 64 + d] = q;
        ks[t * GP + d] = k * __expf(-bb); kd[t * GP + d] = k * __expf(bl - bb); }
    if (tid < 64) ((float*)(ws + WS_CD))[(size_t)((b * 4 + h) * 64 + n) * 64 + tid] = __expf(bc[63 * GP + tid]);
    __syncthreads();
    const int wid = tid >> 6, lane = tid & 63, r32 = lane & 31, hi = lane >> 5;
    if (wid < 4) {
        const int rb = wid >> 1, cb = wid & 1; const f32x16 c = lds_mm32(qs, GP, 1, ks, 1, GP, rb, cb, r32, hi);
#pragma unroll
        for (int r = 0; r < 16; ++r) { const int t = rb * 32 + grow(r, hi), sx = cb * 32 + r32; Am[t * GP + sx] = (sx <= t) ? c[r] : 0.f; }
    }
    __syncthreads();
    const int rb = wid >> 2, cb = wid & 3;
    {
        const f32x16 c = lds_mm32(Am, GP, 1, vs, 128, 1, rb, cb, r32, hi);
        float* OI = (float*)(ws + WS_OI) + (size_t)(t0 + rb * 32) * 512 + h * 128 + cb * 32 + r32;
#pragma unroll
        for (int r = 0; r < 16; ++r) OI[(size_t)grow(r, hi) * 512] = c[r];
    }
    {
        const f32x16 c = lds_mm32(kd, 1, GP, vs, 128, 1, rb, cb, r32, hi);
        float* KV = (float*)(ws + WS_KV) + (size_t)((b * 4 + h) * 64 + n) * 8192 + (rb * 32) * 128 + cb * 32 + r32;
#pragma unroll
        for (int r = 0; r < 16; ++r) KV[grow(r, hi) * 128] = c[r];
    }
}
__device__ __forceinline__ void gla_p2(const Args& a, int blk) {
    unsigned char* ws = a.ws; const int tid = tid_opaque();
    if (tid >= 256) return;
    const int bh = blk >> 5, e = (blk & 31) * 256 + tid, d = e >> 7;
    const float* __restrict__ KV = (const float*)(ws + WS_KV) + (size_t)bh * 64 * 8192 + e;
    float* __restrict__ ST = (float*)(ws + WS_ST) + (size_t)bh * 64 * 8192 + e;
    const float* __restrict__ CD = (const float*)(ws + WS_CD) + (size_t)bh * 64 * 64 + d;
    float st = 0.f;
#pragma unroll 8
    for (int n = 0; n < 64; ++n) { const float kv = KV[(size_t)n * 8192], cd = CD[n * 64]; ST[(size_t)n * 8192] = st; st = cd * st + kv; }
}
__device__ __forceinline__ void gla_p3(const Args& a, int l, int unit, LAS float* L) {
    unsigned char* ws = a.ws; const int tid = tid_opaque();
    const int n = unit & 63, h = (unit >> 6) & 3, b = unit >> 8;
    const int t0 = b * S_ + n * 64;
    LAS float* qs = L; LAS float* ss = qs + 64 * GP;
    __syncthreads();
    const float* QD = (const float*)(ws + WS_QD);
    const float* ST = (const float*)(ws + WS_ST) + (size_t)((b * 4 + h) * 64 + n) * 8192;
    {
        f32x4 qv[2], sv[4];
#pragma unroll
        for (int i = 0; i < 2; ++i) { const int c = tid + i * NTHR, t = c >> 4, part = c & 15; qv[i] = *(const f32x4*)(QD + (size_t)(t0 + t) * 256 + h * 64 + part * 4); }
#pragma unroll
        for (int i = 0; i < 4; ++i) sv[i] = *((const f32x4*)ST + tid + i * NTHR);
#pragma unroll
        for (int i = 0; i < 2; ++i) { const int c = tid + i * NTHR, t = c >> 4, part = c & 15; LAS float* q_ = qs + t * GP + part * 4; q_[0] = qv[i][0]; q_[1] = qv[i][1]; q_[2] = qv[i][2]; q_[3] = qv[i][3]; }
#pragma unroll
        for (int i = 0; i < 4; ++i) *((LAS f32x4*)ss + tid + i * NTHR) = sv[i];
    }
    __syncthreads();
    const int wid = tid >> 6, lane = tid & 63, r32 = lane & 31, hi = lane >> 5, rb = wid >> 2, cb = wid & 3;
    f32x16 c = lds_mm32(qs, GP, 1, ss, 128, 1, rb, cb, r32, hi);
    const float* OI = (const float*)(ws + WS_OI) + (size_t)(t0 + rb * 32) * 512 + h * 128 + cb * 32 + r32;
    LAS float* red = ss + 8192;
#pragma unroll
    for (int r = 0; r < 16; ++r) { c[r] += OI[(size_t)grow(r, hi) * 512]; float q = c[r] * c[r];
#pragma unroll
        for (int o = 1; o < 32; o <<= 1) q += __shfl_xor(q, o);
        if (r32 == 0) red[(rb * 32 + grow(r, hi)) * 4 + cb] = q; }
    __syncthreads();
    const bf16_t* Z = (const bf16_t*)(ws + WS_Z); bf16_t* OG = (bf16_t*)(ws + WS_ACT);
    const float gn = a.in[I_GLAN][l * 512 + h * 128 + cb * 32 + r32];
#pragma unroll
    for (int r = 0; r < 16; ++r) { const int tl = rb * 32 + grow(r, hi); const f32x4 pq = *(const LAS f32x4*)(red + tl * 4);
        const float rstd = 1.0f / sqrtf(((pq[0] + pq[1]) + (pq[2] + pq[3])) * (1.0f / 128.0f) + EPS_);
        const size_t t = (size_t)(t0 + tl); const float rg = bf2f(Z[t * ZP + OFF_GR + h * 128 + cb * 32 + r32]);
        const float o = c[r] * rstd * gn * (rg * pg8::sigm(rg));
        OG[t * 2048 + 1024 + h * 128 + cb * 32 + r32] = (bf16_t)(cvt_pk_bf16(o, 0.f) & 0xffffu); }
}

constexpr int KPITCH = 400, VPITCH = 144, KSLOT = 64 * KPITCH, VSLOT = 128 * VPITCH;
__device__ __forceinline__ int crow(int r, int hi) { return (r & 3) + 8 * (r >> 2) + 4 * hi; }
__device__ __forceinline__ void mla_unit(const Args& a, int b, int h, int qb, LAS unsigned char* lds) {
    unsigned char* ws = a.ws;
    const int tid = tid_opaque(), lane = tid & 63, wid = __builtin_amdgcn_readfirstlane(tid >> 6), wq = wid & 3, grp = wid >> 2, r32 = lane & 31, hi = lane >> 5;
    const bf16_t* Qb = (const bf16_t*)(ws + WS_QB); const bf16_t* Kn = (const bf16_t*)(ws + WS_KN); const bf16_t* Kpe = (const bf16_t*)(ws + WS_KPE);
    const bf16_t* VT = (const bf16_t*)(ws + WS_VT); bf16_t* OM = (bf16_t*)(ws + WS_ACT);
    LAS unsigned char* Kl = lds; LAS unsigned char* Vl = lds + 2 * KSLOT;
    const int pos = qb * 128 + wq * 32 + r32; const size_t qrow = (size_t)b * S_ + pos;
    bf16x8 qf[12];
    {
        const bf16_t* qp = Qb + qrow * 1536 + h * 192;
#pragma unroll
        for (int d0 = 0; d0 < 8; ++d0) qf[d0] = *(const bf16x8*)(qp + 16 * d0 + 8 * hi);
        const f32x2* cs = (const f32x2*)(ws + WS_CS) + pos * 32;
#pragma unroll
        for (int d0 = 8; d0 < 12; ++d0) {
            const int i0 = 16 * (d0 - 8) + 8 * hi, ib = i0 & 31;
            const u32x4 w1 = *(const u32x4*)(qp + 128 + ib), w2 = *(const u32x4*)(qp + 160 + ib);
            const float x1[8] = {bflo(w1.x), bfhi(w1.x), bflo(w1.y), bfhi(w1.y), bflo(w1.z), bfhi(w1.z), bflo(w1.w), bfhi(w1.w)};
            const float x2[8] = {bflo(w2.x), bfhi(w2.x), bflo(w2.y), bfhi(w2.y), bflo(w2.z), bfhi(w2.z), bflo(w2.w), bfhi(w2.w)};
            float o[8];
#pragma unroll
            for (int j = 0; j < 8; ++j) { const f32x2 c = cs[ib + j]; o[j] = (i0 < 32) ? (x1[j] * c.x - x2[j] * c.y) : (x2[j] * c.x + x1[j] * c.y); }
            u32x4 w; w.x = cvt_pk_bf16(o[0], o[1]); w.y = cvt_pk_bf16(o[2], o[3]); w.z = cvt_pk_bf16(o[4], o[5]); w.w = cvt_pk_bf16(o[6], o[7]);
            qf[d0] = __builtin_bit_cast(bf16x8, w);
        }
    }
    float mrun = -1e30f, lsum = 0.f;
    f32x16 oT[4];
#pragma unroll
    for (int i = 0; i < 4; ++i)
#pragma unroll
        for (int r = 0; r < 16; ++r) oT[i][r] = 0.f;
    const float SC = 0.07216878364870322f * 1.4426950408889634f;
    const int npairs = qb + 1;
    u32x4 pf[10];
    const unsigned rb0 = (unsigned)b * S_;
#define MLA_KROW(k) (((k) & ~12u) | (((k) & 4u) << 1) | (((k) & 8u) >> 1))
#define MLA_MAP() unsigned gsrc[5], ldst[5]; { int t2 = tid; asm volatile("" : "+v"(t2)); \
        _Pragma("unroll") for (int i = 0; i < 2; ++i) { const unsigned cc = t2 + i * NTHR, key = cc >> 4, part = cc & 15; gsrc[i] = (unsigned)WS_KN + ((rb0 + key) * 1024 + h * 128 + part * 8) * 2; ldst[i] = MLA_KROW(key) * KPITCH + part * 16; } \
        { const unsigned key = t2 >> 3, part = t2 & 7; gsrc[2] = (unsigned)WS_KPE + ((rb0 + key) * 64 + part * 8) * 2; ldst[2] = MLA_KROW(key) * KPITCH + 256 + part * 16; } \
        _Pragma("unroll") for (int i = 0; i < 2; ++i) { const unsigned c3 = t2 + i * NTHR, dv = c3 >> 3, part = c3 & 7; gsrc[3 + i] = (unsigned)WS_VT + ((h * 128 + dv) * (unsigned)T_ + rb0 + part * 8) * 2; ldst[3 + i] = 2 * KSLOT + dv * VPITCH + part * 16; } }
#define MLA_LOAD(tile0) do { MLA_MAP(); (void)ldst; _Pragma("unroll") for (int sl = 0; sl < 2; ++sl) { const unsigned tt = (unsigned)((tile0) + sl); \
        pf[sl * 5 + 0] = *(const u32x4*)(ws + (size_t)(gsrc[0] + tt * 131072u)); pf[sl * 5 + 1] = *(const u32x4*)(ws + (size_t)(gsrc[1] + tt * 131072u)); pf[sl * 5 + 2] = *(const u32x4*)(ws + (size_t)(gsrc[2] + tt * 8192u)); \
        pf[sl * 5 + 3] = *(const u32x4*)(ws + (size_t)(gsrc[3] + tt * 128u)); pf[sl * 5 + 4] = *(const u32x4*)(ws + (size_t)(gsrc[4] + tt * 128u)); } } while (0)
#define MLA_STORE() do { MLA_MAP(); (void)gsrc; _Pragma("unroll") for (int sl = 0; sl < 2; ++sl) { \
        *(LAS u32x4*)(lds + sl * KSLOT + ldst[0]) = pf[sl * 5 + 0]; *(LAS u32x4*)(lds + sl * KSLOT + ldst[1]) = pf[sl * 5 + 1]; *(LAS u32x4*)(lds + sl * KSLOT + ldst[2]) = pf[sl * 5 + 2]; \
        *(LAS u32x4*)(lds + sl * VSLOT + ldst[3]) = pf[sl * 5 + 3]; *(LAS u32x4*)(lds + sl * VSLOT + ldst[4]) = pf[sl * 5 + 4]; } } while (0)
    __syncthreads();
    MLA_LOAD(0);
    MLA_STORE();
    for (int jp = 0; jp < npairs; ++jp) {
        __syncthreads();
        if (jp + 1 < npairs) MLA_LOAD(2 * (jp + 1));
        const LAS unsigned char* Kt = Kl + grp * KSLOT; const LAS unsigned char* Vt = Vl + grp * VSLOT;
        f32x16 s0, s1;
#pragma unroll
        for (int r = 0; r < 16; ++r) { s0[r] = 0.f; s1[r] = 0.f; }
#pragma unroll
        for (int d0 = 0; d0 < 12; ++d0) {
            const bf16x8 a0 = *(const LAS bf16x8*)(Kt + r32 * KPITCH + d0 * 32 + hi * 16);
            const bf16x8 a1 = *(const LAS bf16x8*)(Kt + (32 + r32) * KPITCH + d0 * 32 + hi * 16);
            s0 = __builtin_amdgcn_mfma_f32_32x32x16_bf16(a0, qf[d0], s0, 0, 0, 0);
            s1 = __builtin_amdgcn_mfma_f32_32x32x16_bf16(a1, qf[d0], s1, 0, 0, 0);
        }
        const bool diag = (jp == npairs - 1); const int qrel = wq * 32 + r32;
        float mx = -INFINITY;
        if (diag) {
#pragma unroll
            for (int r = 0; r < 16; ++r) { const int k0 = grp * 64 + 16 * (r >> 3) + 8 * hi + (r & 7); if (k0 > qrel) s0[r] = -INFINITY; if (k0 + 32 > qrel) s1[r] = -INFINITY; }
        }
#pragma unroll
        for (int r = 0; r < 16; ++r) mx = fmaxf(mx, fmaxf(s0[r], s1[r]));
        mx = fmaxf(mx, __shfl_xor(mx, 32)) * SC;
        const float mnew = fmaxf(mrun, mx);
        if (__any(mnew > mrun)) {
            const float alpha = __builtin_amdgcn_exp2f(mrun - mnew); mrun = mnew; lsum *= alpha;
#pragma unroll
            for (int i = 0; i < 4; ++i)
#pragma unroll
                for (int r = 0; r < 16; ++r) oT[i][r] *= alpha;
        }
        float ps = 0.f;
#pragma unroll
        for (int r = 0; r < 16; ++r) { s0[r] = __builtin_amdgcn_exp2f(__builtin_fmaf(s0[r], SC, -mrun)); s1[r] = __builtin_amdgcn_exp2f(__builtin_fmaf(s1[r], SC, -mrun)); ps += s0[r] + s1[r]; }
        lsum += ps;
#pragma unroll
        for (int kb = 0; kb < 2; ++kb)
#pragma unroll
            for (int hf = 0; hf < 2; ++hf) {
                u32x4 pw;
                if (kb == 0) { pw.x = cvt_pk_bf16(s0[8 * hf + 0], s0[8 * hf + 1]); pw.y = cvt_pk_bf16(s0[8 * hf + 2], s0[8 * hf + 3]); pw.z = cvt_pk_bf16(s0[8 * hf + 4], s0[8 * hf + 5]); pw.w = cvt_pk_bf16(s0[8 * hf + 6], s0[8 * hf + 7]); }
                else { pw.x = cvt_pk_bf16(s1[8 * hf + 0], s1[8 * hf + 1]); pw.y = cvt_pk_bf16(s1[8 * hf + 2], s1[8 * hf + 3]); pw.z = cvt_pk_bf16(s1[8 * hf + 4], s1[8 * hf + 5]); pw.w = cvt_pk_bf16(s1[8 * hf + 6], s1[8 * hf + 7]); }
                const bf16x8 pb = __builtin_bit_cast(bf16x8, pw);
                const int kbase = kb * 32 + 16 * hf + 8 * hi;
#pragma unroll
                for (int dvb = 0; dvb < 4; ++dvb) {
                    const bf16x8 av = *(const LAS bf16x8*)(Vt + (dvb * 32 + r32) * VPITCH + kbase * 2);
                    oT[dvb] = __builtin_amdgcn_mfma_f32_32x32x16_bf16(av, pb, oT[dvb], 0, 0, 0);
                }
            }
        __syncthreads();
        if (jp + 1 < npairs) MLA_STORE();
    }
#undef MLA_LOAD
#undef MLA_STORE
#undef MLA_MAP
#undef MLA_KROW
    __syncthreads();
    LAS float* cb = (LAS float*)lds + (size_t)wq * 66 * 64 + lane;
    if (grp == 1) {
        cb[0] = mrun; cb[64] = lsum;
#pragma unroll
        for (int i = 0; i < 4; ++i)
#pragma unroll
            for (int r = 0; r < 16; ++r) cb[(2 + i * 16 + r) * 64] = oT[i][r];
    }
    __syncthreads();
    if (grp == 0) {
        const float m1 = cb[0], l1 = cb[64];
        const float mN = fmaxf(mrun, m1), w0 = __builtin_amdgcn_exp2f(mrun - mN), w1 = __builtin_amdgcn_exp2f(m1 - mN);
        float lt = lsum * w0 + l1 * w1; lt += __shfl_xor(lt, 32);
        const float inv = 1.0f / lt;
        bf16_t* op = OM + qrow * 2048 + h * 128;
#pragma unroll
        for (int i = 0; i < 4; ++i)
#pragma unroll
            for (int rq = 0; rq < 4; ++rq) {
                float o[4];
#pragma unroll
                for (int j = 0; j < 4; ++j) { const int r = rq * 4 + j; o[j] = (oT[i][r] * w0 + cb[(2 + i * 16 + r) * 64] * w1) * inv; }
                u32x2 w; w.x = cvt_pk_bf16(o[0], o[1]); w.y = cvt_pk_bf16(o[2], o[3]);
                *(u32x2*)(op + i * 32 + 8 * rq + 4 * hi) = w;
            }
    }
    __syncthreads();
}

constexpr int NS = 19;
struct Extra { const bf16_t* A1; const bf16_t* B1; int M1, N1; const bf16_t* A2; const bf16_t* B2; int M2, N2; };
template <class Epi>
__device__ __forceinline__ void run_gemm(LAS unsigned char* lds, const bf16_t* A, int lda, const bf16_t* Bt, int ldb, int M, int N, int K,
                                         int nz, int nzh, long sAb, long sAh, long sBb, long sBh, const Epi& E, const Extra X = Extra{nullptr, nullptr, 256, 0, nullptr, nullptr, 256, 0}, const float* ssp = nullptr, int fmode = 0, int fz = 0, int fpm = 0) {
    const int nM1 = X.M1 / 256, cnt1 = nM1 * (X.N1 / 256), nM2 = X.M2 / 256, cnt2 = nM2 * (X.N2 / 256);
    pg8::Gemm g{A, Bt, M, N, K, lda, ldb, nz, nzh, sAb, sAh, sBb, sBh, X.A1, X.B1, nM1, cnt1, X.A2, X.B2, nM2, cnt2};
    int bidx = (int)blockIdx.x; asm volatile("" : "+s"(bidx));
    pg8::StaticOrder S; S.init(M, N, nz, (int)gridDim.x, bidx, nM1, cnt1, nM2, cnt2); S.fmode = fmode; S.fz = fz; S.fpm = fpm;
    if (ssp) {
        LAS float* rsl = (LAS float*)(lds + LDS_RS_OFF); const int t2 = tid_opaque(); pg8::Unit u;
        for (int i = 0; S.next(i, u); ++i) if (u.grp == 0 && i < 14) {
            const int r = t2 >> 1; const f32x4* pp = (const f32x4*)(ssp + ((size_t)u.z * M + u.pm * 256 + r) * 32 + (t2 & 1) * 16);
            f32x4 a4 = pp[0] + pp[1] + pp[2] + pp[3]; float sm = (a4[0] + a4[1]) + (a4[2] + a4[3]); sm += __shfl_xor(sm, 1);
            if ((t2 & 1) == 0) rsl[i * 256 + r] = 1.0f / sqrtf(sm * (1.0f / 2048.0f) + EPS_);
        }
        __syncthreads();
    }

#ifndef NO_GEMM
    pg8::gemm_phase<Epi>(lds, g, S, E);
#endif

}

__global__ void __launch_bounds__(NTHR, 2) mega(Args a) {
    extern __shared__ __attribute__((aligned(16))) unsigned char lds_raw[];
    LAS unsigned char* lds = (LAS unsigned char*)lds_raw;
    cg::grid_group grid = cg::this_grid();
    unsigned char* ws = a.ws;
    const int G = gridDim.x, blk = blockIdx.x;
    const int NGW = G * 8;
    if (threadIdx.x < 8) ((LAS unsigned*)(lds + LDS_ST_OFF))[threadIdx.x] = 0u;
    __syncthreads();
    const XcdBarrier xbar = xcd_barrier_post((unsigned*)(ws + WS_CTL), (volatile LAS unsigned*)(lds + LDS_ST_OFF));

#pragma unroll 1
    for (int step = a.lo; step < a.hi; ++step) {
        { const int s_ = step % NS; if (step < 2 * NS && (s_ == 3 || s_ == 10 || s_ == 16 || s_ == 13 || s_ == 14 || s_ == 11)) continue; }
        if (step == 2 * NS && G == 256) break;
        if (step > a.lo) { if (a.hi > 1000) grid.sync(); else xcd_barrier(xbar); }
        const int tid = tid_opaque(), lane = tid & 63, wave = __builtin_amdgcn_readfirstlane(tid >> 6);
        const int gw = blk * 8 + wave;
        bf16_t* XN = (bf16_t*)(ws + WS_XN); bf16_t* HBF = (bf16_t*)(ws + WS_HBF);
        if (step == 2 * NS) {
            for (int t = gw; t < T_; t += NGW) rms_row_f32(a.out + (size_t)t * D_, a.in[I_FINN], lane);
            continue;
        }
        const int l = step / NS, s = step % NS;
        const float* hsrc = (l == 0) ? a.in[I_X] : a.out;
        switch (s) {
        case 0: {
            LAS float* scr = (LAS float*)(lds + wave * 16384);
#pragma unroll 1
            for (int j = 0; j < 16; ++j) {
                if (l == 1 && (j == 0 || j == 1 || j == 9 || j == 10 || j == 13)) continue;
                convert_job(a, l, j, scr, gw, NGW, lane);
            }
            if (l == 0) {
                for (int e = blk * NTHR + tid; e < S_ * 32; e += G * NTHR) {
                    const int pos = e >> 5, i = e & 31;
                    double invf = 1.0;
                    for (int k = 0; k < i; ++k) invf *= 0.74989420933245582730;
                    const double rev = (double)pos * invf * 0.15915494309189533577;
                    const float fr = (float)(rev - floor(rev));
                    ((f32x2*)(ws + WS_CS))[e] = (f32x2){__builtin_amdgcn_cosf(fr), __builtin_amdgcn_sinf(fr)};
                }
            }
            for (int r = gw; r < 512; r += NGW) rms_row_bf16(a.in[I_MEM] + (size_t)r * D_, a.in[I_MEMN] + l * D_, (bf16_t*)(ws + WS_MEMN) + (size_t)r * D_, lane);
            if (l == 0) {
                float* SS = (float*)(ws + WS_SS);
                for (int t = gw; t < T_; t += NGW) {
                    const f32x4* xr = (const f32x4*)(a.in[I_X] + (size_t)t * D_) + lane; u32x2* o8 = (u32x2*)(HBF + (size_t)t * D_) + lane; float sq = 0.f;
#pragma unroll
                    for (int j = 0; j < 8; ++j) { const f32x4 v = xr[64 * j]; sq += (v[0] * v[0] + v[1] * v[1]) + (v[2] * v[2] + v[3] * v[3]);
                        u32x2 w; w.x = cvt_pk_bf16(v[0], v[1]); w.y = cvt_pk_bf16(v[2], v[3]); o8[64 * j] = w; }
                    sq = wave_sum(sq); if (lane < 32) SS[(size_t)t * 32 + lane] = (lane == 0) ? sq : 0.f;
                }
            }
        } break;
        case 1: case 17: {
            pg8::EpiSwiglu E; E.nzh = 1; E.sCb = 0; E.sCh = 0; E.O1 = nullptr; E.ldc1 = 0; E.O2 = nullptr; E.ldc2 = 0; E.O = (bf16_t*)(ws + WS_HB); E.ldc = F_;
            E.rowss = (const LAS float*)(lds + LDS_RS_OFF); const float* ssp = (const float*)(ws + WS_SS) + (size_t)(l * 4 + (s == 1 ? 0 : 3)) * T_ * 32;
            Extra X{(const bf16_t*)(ws + WS_MEMN), (const bf16_t*)(ws + WS_WXK), 512, s == 1 ? D_ : 0, (const bf16_t*)(ws + WS_MEMN), (const bf16_t*)(ws + WS_WXV), 512, s == 1 ? D_ : 0};
            E.O1 = (bf16_t*)(ws + WS_KM); E.ldc1 = D_; E.O2 = (bf16_t*)(ws + WS_VMT); E.ldc2 = D_;
            run_gemm(lds, HBF, D_, (const bf16_t*)(ws + (s == 1 ? WS_W1I : WS_W2I)), D_, T_, 2 * F_, D_, 1, 1, 0, 0, 0, 0, E, X, ssp);
            if (s == 17 && l == 0 && G == 256 && blk >= 128) {
                __syncthreads(); LAS float* scr = (LAS float*)(lds + wave * 16384);
                convert_job(a, 1, 9, scr, (blk - 128) * 8 + wave, 128 * 8, lane); convert_job(a, 1, 10, scr, (blk - 128) * 8 + wave, 128 * 8, lane); convert_job(a, 1, 13, scr, (blk - 128) * 8 + wave, 128 * 8, lane);
            }
        } break;
        case 2: case 18: {
            pg8::EpiResid E; E.nzh = 1; E.sCb = 0; E.sCh = 0; E.O1 = nullptr; E.ldc1 = 0; E.O2 = nullptr; E.ldc2 = 0; E.resid = (s == 2) ? hsrc : a.out; E.out = a.out; E.ldc = D_; E.zrows = 0; E.scale = 0.5f; E.hb = HBF; E.ss = (float*)(ws + WS_SS) + (size_t)(s == 2 ? l * 4 + 1 : (l + 1) * 4) * T_ * 32;
            if (s == 18 && l == 1 && G == 256) {
                pg8::EpiFinal EF; EF.nzh = 1; EF.sCb = 0; EF.sCh = 0; EF.O1 = nullptr; EF.ldc1 = 0; EF.O2 = nullptr; EF.ldc2 = 0; EF.resid = a.out; EF.out = a.out; EF.g = a.in[I_FINN];
                EF.xpart = (float*)(ws + WS_SS) + (size_t)8 * T_ * 32; EF.cnt = (unsigned*)(ws + WS_CTL) + CW_PANEL; EF.tab = (LAS float*)(lds + LDS_RS_OFF); EF.ldc = D_; EF.scale = 0.5f;
                run_gemm(lds, (const bf16_t*)(ws + WS_HB), F_, (const bf16_t*)(ws + WS_W2O), F_, T_, D_, F_, 1, 1, 0, 0, 0, 0, EF);
            } else
            run_gemm(lds, (const bf16_t*)(ws + WS_HB), F_, (const bf16_t*)(ws + (s == 2 ? WS_W1O : WS_W2O)), F_, T_, D_, F_, 1, 1, 0, 0, 0, 0, E);
        } break;
        case 3: case 10: case 16: {
            const float* g = a.in[s == 3 ? I_MIXN : (s == 10 ? I_XN : I_F2N)] + l * D_;
            for (int t = gw; t < T_; t += NGW) rms_row_bf16(a.out + (size_t)t * D_, g, XN + (size_t)t * D_, lane);
        } break;
        case 4: {
            pg8::EpiBf16 E; E.nzh = 1; E.sCb = 0; E.sCh = 0; E.O1 = nullptr; E.ldc1 = 0; E.O2 = nullptr; E.ldc2 = 0; E.O = (bf16_t*)(ws + WS_Z); E.ldc = ZP; E.scale = 1.f; E.rowss = (const LAS float*)(lds + LDS_RS_OFF);
            run_gemm(lds, HBF, D_, (const bf16_t*)(ws + WS_WIN), D_, T_, ZP, D_, 1, 1, 0, 0, 0, 0, E, Extra{nullptr, nullptr, 256, 0, nullptr, nullptr, 256, 0}, (const float*)(ws + WS_SS) + (size_t)(l * 4 + 1) * T_ * 32);
            if (l == 0 && G == 256 && blk >= 32) {
                __syncthreads(); LAS float* scr = (LAS float*)(lds + wave * 16384);
                convert_job(a, 1, 0, scr, (blk - 32) * 8 + wave, 224 * 8, lane); convert_job(a, 1, 1, scr, (blk - 32) * 8 + wave, 224 * 8, lane);
            }
        } break;
        case 5: {

#ifndef NO_MIXROW
 for (int t = gw; t < T_; t += NGW) mixer_row(a, l, t, lane);
#endif


#ifndef NO_GLA
 for (int u = blk; u < 512; u += G) gla_p1(a, l, u, (LAS float*)lds);
#endif

        } break;
        case 6: {
            for (int u = blk; u < 256; u += G) gla_p2(a, u);
            pg8::EpiBf16 E; E.nzh = 1; E.sCb = 0; E.sCh = 0; E.O1 = nullptr; E.ldc1 = 0; E.O2 = nullptr; E.ldc2 = 0; E.scale = 1.f; E.rowss = nullptr;
            E.O = (bf16_t*)(ws + WS_QB); E.ldc = 1536; E.O1 = (bf16_t*)(ws + WS_KN); E.ldc1 = 1024; E.O2 = (bf16_t*)(ws + WS_VT); E.ldc2 = T_;
            Extra X{(const bf16_t*)(ws + WS_CKVN), (const bf16_t*)(ws + WS_WUK), T_, 1024, (const bf16_t*)(ws + WS_WUV), (const bf16_t*)(ws + WS_CKVN), 1024, T_};
            run_gemm(lds, (const bf16_t*)(ws + WS_CQN), 512, (const bf16_t*)(ws + WS_WUQ), 512, T_, 1536, 512, 1, 1, 0, 0, 0, 0, E, X);
            pg8::EpiBf16 E3; E3.O1 = nullptr; E3.ldc1 = 0; E3.O2 = nullptr; E3.ldc2 = 0; E3.nzh = 4; E3.sCb = (long)1024 * D_; E3.sCh = (long)256 * D_; E3.O = (bf16_t*)(ws + WS_QX); E3.ldc = D_; E3.scale = 1.f; E3.rowss = nullptr;
            run_gemm(lds, (const bf16_t*)(ws + WS_KM), D_, (const bf16_t*)(ws + WS_WXQ), D_, 256, D_, 512, 8, 4, (long)256 * D_, 512, 0, 512, E3);
            E3.sCb = (long)D_ * 1024; E3.sCh = 256; E3.O = (bf16_t*)(ws + WS_OX); E3.ldc = 1024;
            run_gemm(lds, (const bf16_t*)(ws + WS_WXO), D_, (const bf16_t*)(ws + WS_VMT), D_, D_, 256, 512, 8, 4, 0, 512, (long)256 * D_, 512, E3);
        } break;
        case 7: {
            for (int c = blk; c < 256; c += G) { const int bh = c >> 4, x = c & 15;
#ifndef NO_MLA
 mla_unit(a, bh >> 3, bh & 7, x, lds); mla_unit(a, bh >> 3, bh & 7, 31 - x, lds);
#endif
 }

#ifndef NO_GLA
 for (int u = blk; u < 512; u += G) gla_p3(a, l, u, (LAS float*)lds);
#endif

            __syncthreads();
        } break;
        case 8: {
            pg8::EpiGate3 E; E.nzh = 1; E.sCb = 0; E.sCh = 0; E.O1 = nullptr; E.ldc1 = 0; E.O2 = nullptr; E.ldc2 = 0;
            E.Zg = (const bf16_t*)(ws + WS_Z) + OFF_GATE; E.bg = a.in[I_BGATE] + l * 3 * D_; E.XN = XN;
            run_gemm(lds, (const bf16_t*)(ws + WS_ACT), D_, (const bf16_t*)(ws + WS_WPM), D_, T_, D_, D_, 1, 1, 0, 0, 0, 0, E);
        } break;
        case 9: case 15: {
            pg8::EpiResid E; E.nzh = 1; E.sCb = 0; E.sCh = 0; E.O1 = nullptr; E.ldc1 = 0; E.O2 = nullptr; E.ldc2 = 0; E.resid = a.out; E.out = a.out; E.ldc = D_; E.zrows = 0; E.scale = 1.f; E.hb = HBF; E.ss = (float*)(ws + WS_SS) + (size_t)(l * 4 + (s == 9 ? 2 : 3)) * T_ * 32;
            if (s == 9) run_gemm(lds, (const bf16_t*)XN, D_, (const bf16_t*)(ws + WS_WMO), D_, T_, D_, D_, 1, 1, 0, 0, 0, 0, E);
            else { E.zrows = S_;
                run_gemm(lds, (const bf16_t*)(ws + WS_PX), 1024, (const bf16_t*)(ws + WS_OX), 1024, S_, D_, 1024, 2, 1, (long)S_ * 1024, 0, (long)D_ * 1024, 0, E); }
        } break;
        case 11: {
            pg8::EpiBf16 E; E.nzh = 1; E.sCb = 0; E.sCh = 0; E.O1 = nullptr; E.ldc1 = 0; E.O2 = nullptr; E.ldc2 = 0; E.O = (bf16_t*)(ws + WS_QX); E.ldc = D_; E.scale = 1.f; E.rowss = (const LAS float*)(lds + LDS_RS_OFF);
            run_gemm(lds, HBF, D_, (const bf16_t*)(ws + WS_WXQ), D_, T_, D_, D_, 1, 1, 0, 0, 0, 0, E, Extra{nullptr, nullptr, 256, 0, nullptr, nullptr, 256, 0}, (const float*)(ws + WS_SS) + (size_t)(l * 4 + 2) * T_ * 32);
        } break;
        case 12: {
            pg8::EpiSoftmax E; E.O1 = nullptr; E.ldc1 = 0; E.O2 = nullptr; E.ldc2 = 0; E.nzh = 1; E.sCb = (long)S_ * 1024; E.sCh = 0; E.P = (bf16_t*)(ws + WS_PX); E.red = (LAS float*)(lds + LDS_RS_OFF + 4096);
            E.rowss = (const LAS float*)(lds + LDS_RS_OFF); E.ldc = 1024; E.scale = 0.044194173824159216f;
            run_gemm(lds, HBF, D_, (const bf16_t*)(ws + WS_QX), D_, S_, 1024, D_, 2, 1, (long)S_ * D_, 0, (long)1024 * D_, 0, E,
                     Extra{nullptr, nullptr, 256, 0, nullptr, nullptr, 256, 0}, (const float*)(ws + WS_SS) + (size_t)(l * 4 + 2) * T_ * 32);
        } break;
        default: break;
        }
    }
}

extern "C" void kernel_launch(void* const* d_in, const int* in_sizes, int n_in, void* d_out, int out_size, void* d_ws, size_t ws_size, hipStream_t stream) {
    static int grid = 0;
    if (grid == 0) {
        if (n_in != 29 || out_size != T_ * D_ || ws_size < WS_END) { fprintf(stderr, "kernel_launch: unexpected problem (n_in %d out %d ws %zu need %zu)\n", n_in, out_size, ws_size, (size_t)WS_END); grid = -1; return; }
        int dev = 0, cus = 0, per_cu = 0;
        (void)hipGetDevice(&dev); (void)hipDeviceGetAttribute(&cus, hipDeviceAttributeMultiprocessorCount, dev);
        if (hipFuncSetAttribute((const void*)mega, hipFuncAttributeMaxDynamicSharedMemorySize, LDS_BYTES) != hipSuccess) { fprintf(stderr, "kernel_launch: hipFuncSetAttribute failed\n"); grid = -1; return; }
        if (hipOccupancyMaxActiveBlocksPerMultiprocessor(&per_cu, (const void*)mega, NTHR, LDS_BYTES) != hipSuccess || per_cu < 1) { fprintf(stderr, "kernel_launch: occupancy query says %d\n", per_cu); per_cu = 1; }
        (void)hipGetLastError();
        grid = cus;
    }
    if (grid < 0) return;
    if (hipMemsetAsync((char*)d_ws + WS_CTL, 0, CTL_BYTES, stream) != hipSuccess) { fprintf(stderr, "kernel_launch: memset failed\n"); return; }
    Args a{};
    for (int i = 0; i < 29; ++i) a.in[i] = (const float*)d_in[i];
    a.out = (float*)d_out; a.ws = (unsigned char*)d_ws; a.lo = 0; a.hi = 2 * NS + 1;
    void* args[] = {&a};
    hipError_t e = hipLaunchCooperativeKernel((const void*)mega, dim3(grid), dim3(NTHR), args, LDS_BYTES, stream);
    if (e != hipSuccess) fprintf(stderr, "cooperative launch failed: %s (grid %d)\n", hipGetErrorString(e), grid);
}
```

```cpp
#include <hip/hip_runtime.h>
#include <hip/hip_cooperative_groups.h>
#include <cstdio>
#include <cstdint>
namespace cg = cooperative_groups;

#define LAS __attribute__((address_space(3)))
typedef unsigned short bf16_t;
typedef short bf16x8 __attribute__((ext_vector_type(8)));
typedef float f32x4 __attribute__((ext_vector_type(4)));
typedef float f32x2 __attribute__((ext_vector_type(2)));
typedef float f32x16 __attribute__((ext_vector_type(16)));
typedef unsigned u32x4 __attribute__((ext_vector_type(4)));
typedef unsigned u32x2 __attribute__((ext_vector_type(2)));

constexpr int T_ = 8192, D_ = 2048, F_ = 5632, S_ = 4096, NB_ = 2;
constexpr int ZP = 10496, NZIN = 10320;
constexpr int OFF_CQ = 0, OFF_CKV = 512, OFF_KR = 1024, OFF_GQ = 1088, OFF_GK = 1344, OFF_GV = 1600, OFF_GR = 2112, OFF_AL = 2624,
              OFF_CV = 2640, OFF_GATE = 4176;
constexpr float EPS_ = 1e-6f;
constexpr int NTHR = 512;
constexpr int LDS_BYTES = 147456;

constexpr size_t al256(size_t x) { return (x + 255) & ~(size_t)255; }
constexpr size_t WS_W1I = 0;
constexpr size_t WS_W1O = WS_W1I + al256((size_t)2 * F_ * D_ * 2);
constexpr size_t WS_WIN = WS_W1O + al256((size_t)D_ * F_ * 2);
constexpr size_t WS_WUQ = WS_WIN + al256((size_t)ZP * D_ * 2);
constexpr size_t WS_WUK = WS_WUQ + al256((size_t)1536 * 512 * 2);
constexpr size_t WS_WUV = WS_WUK + al256((size_t)1024 * 512 * 2);
constexpr size_t WS_WPM = WS_WUV + al256((size_t)1024 * 512 * 2);
constexpr size_t WS_WPG = WS_WPM + al256((size_t)2048 * 1024 * 2);
constexpr size_t WS_WPC = WS_WPG + al256((size_t)2048 * 512 * 2);
constexpr size_t WS_WMO = WS_WPC + al256((size_t)2048 * 512 * 2);
constexpr size_t WS_WXQ = WS_WMO + al256((size_t)2048 * 2048 * 2);
constexpr size_t WS_WXK = WS_WXQ + al256((size_t)2048 * 2048 * 2);
constexpr size_t WS_WXV = WS_WXK + al256((size_t)2048 * 2048 * 2);
constexpr size_t WS_WXO = WS_WXV + al256((size_t)2048 * 2048 * 2);
constexpr size_t WS_W2I = WS_WXO + al256((size_t)2048 * 2048 * 2);
constexpr size_t WS_W2O = WS_W2I + al256((size_t)2 * F_ * D_ * 2);
constexpr size_t WS_XN  = WS_W2O + al256((size_t)D_ * F_ * 2);
constexpr size_t WS_Z   = WS_XN + al256((size_t)T_ * D_ * 2);
constexpr size_t WS_HB  = WS_Z;
constexpr size_t WS_CQN = WS_Z + al256((size_t)T_ * ZP * 2);
constexpr size_t WS_CKVN = WS_CQN + al256((size_t)T_ * 512 * 2);
constexpr size_t WS_KPE = WS_CKVN + al256((size_t)T_ * 512 * 2);
constexpr size_t WS_YC  = WS_KPE + al256((size_t)T_ * 64 * 2);
constexpr size_t WS_QB  = WS_YC + al256((size_t)T_ * 512 * 2);
constexpr size_t WS_KN  = WS_QB + al256((size_t)T_ * 1536 * 2);
constexpr size_t WS_VT  = WS_KN + al256((size_t)T_ * 1024 * 2);
constexpr size_t WS_OM  = WS_VT + al256((size_t)T_ * 1024 * 2);
constexpr size_t WS_OG  = WS_OM + al256((size_t)T_ * 1024 * 2);
constexpr size_t WS_OI  = WS_OG + al256((size_t)T_ * 512 * 2);
constexpr size_t WS_KV  = WS_OI + al256((size_t)T_ * 512 * 4);
constexpr size_t WS_ST  = WS_KV + al256((size_t)8 * 64 * 8192 * 4);
constexpr size_t WS_CD  = WS_ST + al256((size_t)8 * 64 * 8192 * 4);
constexpr size_t WS_QD  = WS_CD + al256((size_t)8 * 64 * 64 * 4);
constexpr size_t WS_MG  = WS_QD + al256((size_t)T_ * 256 * 4);
constexpr size_t WS_ACT = WS_MG;
constexpr size_t WS_QX  = WS_MG + al256((size_t)T_ * D_ * 4);
constexpr size_t WS_SX  = WS_QX + al256((size_t)T_ * D_ * 2);
constexpr size_t WS_PX  = WS_SX + al256((size_t)T_ * 1024 * 4);
constexpr size_t WS_OX  = WS_PX + al256((size_t)T_ * 1024 * 2);
constexpr size_t WS_MEMN = WS_OX + al256((size_t)T_ * D_ * 2);
constexpr size_t WS_KM  = WS_MEMN + al256((size_t)512 * D_ * 2);
constexpr size_t WS_VMT = WS_KM + al256((size_t)512 * D_ * 2);
constexpr size_t WS_CS  = WS_VMT + al256((size_t)512 * D_ * 2);
constexpr size_t WS_HBF = WS_CS + al256((size_t)4096 * 32 * 2 * 4);
constexpr size_t WS_SS  = WS_HBF + al256((size_t)T_ * D_ * 2);
constexpr size_t WS_CTL = WS_SS + al256((size_t)3 * 4 * T_ * 32 * 4);
constexpr size_t CTL_BYTES = 32768;
constexpr int CW_PANEL = 4096;
constexpr size_t WS_END = WS_CTL + CTL_BYTES;
constexpr int LDS_ST_OFF = 131072 + 320;
constexpr int LDS_RS_OFF = 131072 + 1024;

__device__ __forceinline__ unsigned cvt_pk_bf16(float lo, float hi) { unsigned r; asm volatile("v_cvt_pk_bf16_f32 %0, %1, %2" : "=v"(r) : "v"(lo), "v"(hi)); return r; }
__device__ __forceinline__ float bf2f(unsigned b) { return __uint_as_float(b << 16); }
__device__ __forceinline__ float bflo(unsigned w) { return __uint_as_float(w << 16); }
__device__ __forceinline__ float bfhi(unsigned w) { return __uint_as_float(w & 0xffff0000u); }
__device__ __forceinline__ int tid_opaque() { int t = threadIdx.x; asm volatile("" : "+v"(t)); return t; }
__device__ __forceinline__ float wave_sum(float v) {
#pragma unroll
    for (int o = 1; o < 64; o <<= 1) v += __shfl_xor(v, o);
    return v;
}
__device__ __forceinline__ float wave_max(float v) {
#pragma unroll
    for (int o = 1; o < 64; o <<= 1) v = fmaxf(v, __shfl_xor(v, o));
    return v;
}

namespace pg8 {
constexpr int BM = 256, BK = 64, HALF = 128, HTB = HALF * BK * 2, STAGE_BYTES = 8 * HTB, NXCD = 8, WGM = 8;
__host__ __device__ __forceinline__ int lds_byte(int r, int c) { const int st = (r >> 4) * 2 + (c >> 5), rr = r & 15, cc = c & 31, ob = rr * 64 + cc * 2; return st * 1024 + (ob ^ (((ob >> 9) & 1) << 5)); }
__host__ __device__ __forceinline__ void stage_rc(int b, int& R, int& C) { const int st = b / 1024, sb = b % 1024, swz = sb ^ (((sb >> 9) & 1) << 5); R = (st >> 1) * 16 + swz / 64; C = (st & 1) * 32 + (swz % 64) / 2; }
__host__ __device__ __forceinline__ int perm32(int rho) { const int n = rho >> 4, i = rho & 15; return 8 * (i >> 2) + 4 * n + (i & 3); }

struct Unit { int pm, pn, z, grp, idx; };
struct Gemm { const bf16_t* A; const bf16_t* Bt; int M, N, K, lda, ldb, nz, nzh; long sAb, sAh, sBb, sBh;
              const bf16_t* A1; const bf16_t* B1; int nM1, cnt1; const bf16_t* A2; const bf16_t* B2; int nM2, cnt2; };

struct StaticOrder {
    int nM, nN, nwg, G, c, nz, nM1, cnt1, nM2, cnt2, fmode, fz, fpm;
    __device__ void init(int M, int N, int nz_, int G_, int c_, int nM1_, int cnt1_, int nM2_, int cnt2_) { nM = M / BM; nN = N / BM; nwg = nM * nN; nz = nz_; G = G_; c = c_; nM1 = nM1_; cnt1 = cnt1_; nM2 = nM2_; cnt2 = cnt2_; fmode = 0; fz = 0; fpm = 0; }
    __device__ bool next(int i, Unit& u) const {
        u.idx = i;
        if (fmode != 0) { if (fmode == 2 || i >= nN) return false; u.z = fz; u.pm = fpm; u.pn = i; u.grp = 0; return true; }
        const long L = (long)i * G + c;
        if (L >= (long)nwg * nz) {
            int e = (int)(L - (long)nwg * nz); u.z = 0;
            if (e < cnt1) { u.grp = 1; u.pm = e % nM1; u.pn = e / nM1; return true; }
            e -= cnt1;
            if (e < cnt2) { u.grp = 2; u.pm = e % nM2; u.pn = e / nM2; return true; }
            return false;
        }
        u.grp = 0;
        u.z = (int)(L / nwg);
        int wgid = (int)(L % nwg); { const int q = nwg / NXCD, r = nwg % NXCD, xcd = wgid % NXCD, off = wgid / NXCD; wgid = (xcd < r ? xcd * (q + 1) : r * (q + 1) + (xcd - r) * q) + off; }
        const int nig = WGM * nN, gid = wgid / nig, fm = gid * WGM, gsz = (nM - fm) < WGM ? (nM - fm) : WGM;
        u.pm = fm + ((wgid % nig) % gsz); u.pn = (wgid % nig) / gsz; return true;
    }
};

struct EpiBase { static constexpr bool HOOK = false; int nzh; long sCb, sCh; bf16_t* O1; int ldc1; bf16_t* O2; int ldc2;
    __device__ __forceinline__ long zoff(const Unit& u) const { return (long)(u.z / nzh) * sCb + (long)(u.z % nzh) * sCh; } };
__device__ __forceinline__ float rstd_row(const float* ssp, int row) {
    const f32x4* p = (const f32x4*)(ssp + (size_t)row * 32); f32x4 a = p[0];
#pragma unroll
    for (int i = 1; i < 8; ++i) a += p[i];
    return 1.0f / sqrtf(((a[0] + a[1]) + (a[2] + a[3])) * (1.0f / 2048.0f) + EPS_);
}
__device__ __forceinline__ void store_bf16_perm(const f32x4 (&acc)[2][2][4][2], bf16_t* base, int ldc, float scale0, const LAS float* rowss, const Unit& u, int wr, int wc, int fr, int fq) {
    const int row0 = u.pm * BM + wr * 64 + fr; const int col0 = u.pn * BM + wc * 32 + 8 * fq;
#pragma unroll
    for (int ai = 0; ai < 2; ++ai)
#pragma unroll
        for (int m = 0; m < 4; ++m) { bf16_t* rowp = base + (size_t)(row0 + ai * HALF + m * 16) * ldc + col0;
            const float scale = rowss ? scale0 * rowss[u.idx * 256 + wr * 64 + fr + ai * HALF + m * 16] : scale0;
#pragma unroll
            for (int bj = 0; bj < 2; ++bj) { const f32x4 v0 = acc[ai][bj][m][0] * scale, v1 = acc[ai][bj][m][1] * scale;
                u32x4 w; w.x = cvt_pk_bf16(v0[0], v0[1]); w.y = cvt_pk_bf16(v0[2], v0[3]); w.z = cvt_pk_bf16(v1[0], v1[1]); w.w = cvt_pk_bf16(v1[2], v1[3]);
                *(u32x4*)(rowp + bj * HALF) = w; } }
}

struct EpiBf16 : EpiBase {
    static constexpr bool PERM = true;
    bf16_t* O; const LAS float* rowss; int ldc; float scale;
    __device__ __forceinline__ void operator()(const f32x4 (&acc)[2][2][4][2], const Unit& u, int wr, int wc, int fr, int fq) const {
        bf16_t* o0 = O + zoff(u); bf16_t* o1 = O1; bf16_t* o2 = O2; int l0 = ldc, l1 = ldc1, l2 = ldc2;
        asm volatile("" : "+s"(o0), "+s"(o1), "+s"(o2), "+s"(l0), "+s"(l1), "+s"(l2));
        bf16_t* base = u.grp == 0 ? o0 : (u.grp == 1 ? o1 : o2); const int ld = u.grp == 0 ? l0 : (u.grp == 1 ? l1 : l2);
        store_bf16_perm(acc, base, ld, scale, u.grp == 0 ? rowss : nullptr, u, wr, wc, fr, fq);
    }
};
__device__ __forceinline__ float sigm(float x) { return __builtin_amdgcn_rcpf(1.0f + __builtin_amdgcn_exp2f(-1.4426950408889634f * x)); }
__device__ __forceinline__ float silu_mul(float g, float u) { return g * u * sigm(g); }
struct EpiSwiglu : EpiBase {
    static constexpr bool PERM = true;
    bf16_t* O; int ldc; const LAS float* rowss;
    __device__ __forceinline__ void operator()(const f32x4 (&acc)[2][2][4][2], const Unit& u, int wr, int wc, int fr, int fq) const {
        if (u.grp != 0) { bf16_t* o1 = O1; bf16_t* o2 = O2; int l1 = ldc1, l2 = ldc2; asm volatile("" : "+s"(o1), "+s"(o2), "+s"(l1), "+s"(l2));
            store_bf16_perm(acc, u.grp == 1 ? o1 : o2, u.grp == 1 ? l1 : l2, 1.f, nullptr, u, wr, wc, fr, fq); return; }
        const int row0 = u.pm * BM + wr * 64 + fr; const int col0 = u.pn * HALF + wc * 32 + 8 * fq;
#pragma unroll
        for (int ai = 0; ai < 2; ++ai)
#pragma unroll
            for (int m = 0; m < 4; ++m) { bf16_t* rowp = O + (size_t)(row0 + ai * HALF + m * 16) * ldc + col0;
                const float rs = rowss[u.idx * 256 + wr * 64 + fr + ai * HALF + m * 16];
                const f32x4 g0 = acc[ai][0][m][0] * rs, g1 = acc[ai][0][m][1] * rs, u0 = acc[ai][1][m][0] * rs, u1 = acc[ai][1][m][1] * rs;
                u32x4 w; w.x = cvt_pk_bf16(silu_mul(g0[0], u0[0]), silu_mul(g0[1], u0[1])); w.y = cvt_pk_bf16(silu_mul(g0[2], u0[2]), silu_mul(g0[3], u0[3]));
                w.z = cvt_pk_bf16(silu_mul(g1[0], u1[0]), silu_mul(g1[1], u1[1])); w.w = cvt_pk_bf16(silu_mul(g1[2], u1[2]), silu_mul(g1[3], u1[3]));
                *(u32x4*)rowp = w; }
    }
};
struct EpiResid : EpiBase {
    static constexpr bool PERM = true;
    const float* resid; float* out; bf16_t* hb; float* ss; int zrows; int ldc; float scale;
    __device__ __forceinline__ void operator()(const f32x4 (&acc)[2][2][4][2], const Unit& u, int wr, int wc, int fr, int fq) const {
        const int col0 = u.pn * BM + wc * 32 + 8 * fq;
        const float* const resid = this->resid; float* const out = this->out; const int ldc = this->ldc; const float scale = this->scale; bf16_t* const hb = this->hb; float* const ss = this->ss; const int zrows = this->zrows;
#pragma unroll
        for (int ai = 0; ai < 2; ++ai)
#pragma unroll
            for (int m = 0; m < 4; ++m) { const int row = u.z * zrows + u.pm * BM + ai * HALF + wr * 64 + m * 16 + fr; const size_t off = (size_t)row * ldc + col0;
                float sq = 0.f;
#pragma unroll
                for (int bj = 0; bj < 2; ++bj) { const f32x4 b0 = *(const f32x4*)(resid + off + bj * HALF), b1 = *(const f32x4*)(resid + off + bj * HALF + 4);
                    const f32x4 v0 = b0 + acc[ai][bj][m][0] * scale, v1 = b1 + acc[ai][bj][m][1] * scale;
                    *(f32x4*)(out + off + bj * HALF) = v0; *(f32x4*)(out + off + bj * HALF + 4) = v1;
                    u32x4 w; w.x = cvt_pk_bf16(v0[0], v0[1]); w.y = cvt_pk_bf16(v0[2], v0[3]); w.z = cvt_pk_bf16(v1[0], v1[1]); w.w = cvt_pk_bf16(v1[2], v1[3]); *(u32x4*)(hb + off + bj * HALF) = w;
                    sq += ((v0[0] * v0[0] + v0[1] * v0[1]) + (v0[2] * v0[2] + v0[3] * v0[3])) + ((v1[0] * v1[0] + v1[1] * v1[1]) + (v1[2] * v1[2] + v1[3] * v1[3])); }
                sq += __shfl_xor(sq, 16); sq += __shfl_xor(sq, 32);
                if (fq == 0) ss[(size_t)row * 32 + u.pn * 4 + wc] = sq;
                }
    }
};
struct EpiFinal : EpiBase {
    static constexpr bool PERM = true;
    const float* resid; float* out; const float* g; float* xpart; unsigned* cnt; LAS float* tab; int ldc; float scale;
    __device__ __forceinline__ void operator()(const f32x4 (&acc_)[2][2][4][2], const Unit& u, int wr, int wc, int fr_, int fq) const {
        int fr = fr_; asm volatile("" : "+v"(fr));
        f32x4 (&acc)[2][2][4][2] = const_cast<f32x4 (&)[2][2][4][2]>(acc_);
        const int col0 = u.pn * BM + wc * 32 + 8 * fq; const int lane = fq * 16 + fr; const int tid = (wr * 4 + wc) * 64 + lane;
        const float* const resid = this->resid; float* const out = this->out; const int ldc = this->ldc; const float scale = this->scale;
#pragma unroll
        for (int ai = 0; ai < 2; ++ai)
#pragma unroll
            for (int m = 0; m < 4; ++m) { const int row = u.pm * BM + ai * HALF + wr * 64 + m * 16 + fr; const size_t off = (size_t)row * ldc + col0; float sq = 0.f;
#pragma unroll
                for (int bj = 0; bj < 2; ++bj) { const f32x4 b0 = *(const f32x4*)(resid + off + bj * HALF), b1 = *(const f32x4*)(resid + off + bj * HALF + 4);
                    const f32x4 v0 = b0 + acc[ai][bj][m][0] * scale, v1 = b1 + acc[ai][bj][m][1] * scale; acc[ai][bj][m][0] = v0; acc[ai][bj][m][1] = v1;
                    sq += ((v0[0] * v0[0] + v0[1] * v0[1]) + (v0[2] * v0[2] + v0[3] * v0[3])) + ((v1[0] * v1[0] + v1[1] * v1[1]) + (v1[2] * v1[2] + v1[3] * v1[3])); }
                sq += __shfl_xor(sq, 16); sq += __shfl_xor(sq, 32);
                if (fq == 0) __hip_atomic_store((unsigned*)(xpart + (size_t)row * 32 + u.pn * 4 + wc), __float_as_uint(sq), __ATOMIC_RELAXED, __HIP_MEMORY_SCOPE_AGENT); }
        asm volatile("s_waitcnt vmcnt(0)" ::: "memory");
        unsigned* const pc = cnt + 64 * u.pm;
        if (lane == 0) __hip_atomic_fetch_add(pc, 1u, __ATOMIC_RELAXED, __HIP_MEMORY_SCOPE_AGENT);
        if (tid < 64) {
            unsigned sp = 0;
            while ((unsigned)__builtin_amdgcn_readfirstlane(__hip_atomic_load(pc, __ATOMIC_RELAXED, __HIP_MEMORY_SCOPE_AGENT)) < 64u) { __builtin_amdgcn_s_sleep(2); if (++sp > (1u << 22)) break; }
            __builtin_amdgcn_fence(__ATOMIC_ACQUIRE, "agent");
        }
        asm volatile("s_waitcnt vmcnt(0) lgkmcnt(0)" ::: "memory"); __builtin_amdgcn_s_barrier(); asm volatile("" ::: "memory");
        {
            const int r = tid >> 1; const unsigned* pp = (const unsigned*)(xpart + (size_t)(u.pm * BM + r) * 32 + (tid & 1) * 16); float sm = 0.f;
#pragma unroll
            for (int i = 0; i < 16; ++i) sm += __uint_as_float(__hip_atomic_load(pp + i, __ATOMIC_RELAXED, __HIP_MEMORY_SCOPE_AGENT));
            sm += __shfl_xor(sm, 1);
            if ((tid & 1) == 0) tab[r] = 1.0f / sqrtf(sm * (1.0f / 2048.0f) + EPS_);
        }
        asm volatile("s_waitcnt lgkmcnt(0)" ::: "memory"); __builtin_amdgcn_s_barrier(); asm volatile("" ::: "memory");
#pragma unroll
        for (int bj = 0; bj < 2; ++bj) { const f32x4 g0 = *(const f32x4*)(g + col0 + bj * HALF), g1 = *(const f32x4*)(g + col0 + bj * HALF + 4);
#pragma unroll
            for (int ai = 0; ai < 2; ++ai)
#pragma unroll
                for (int m = 0; m < 4; ++m) { const int rl = ai * HALF + wr * 64 + m * 16 + fr; const float rs = tab[rl]; const size_t off = (size_t)(u.pm * BM + rl) * ldc + col0 + bj * HALF;
                    *(f32x4*)(out + off) = acc[ai][bj][m][0] * rs * g0; *(f32x4*)(out + off + 4) = acc[ai][bj][m][1] * rs * g1; } }
    }
};
struct EpiF32 : EpiBase {
    static constexpr bool PERM = false;
    float* out; int ldc; float scale;
    __device__ __forceinline__ void operator()(const f32x4 (&acc)[2][2][4][2], const Unit& u, int wr, int wc, int fr, int fq) const {
        const int col0 = u.pn * BM + wc * 32 + 4 * fq; float* base = out + zoff(u);
#pragma unroll
        for (int ai = 0; ai < 2; ++ai)
#pragma unroll
            for (int m = 0; m < 4; ++m) { const size_t off = (size_t)(u.pm * BM + ai * HALF + wr * 64 + m * 16 + fr) * ldc + col0;
#pragma unroll
                for (int bj = 0; bj < 2; ++bj)
#pragma unroll
                    for (int n = 0; n < 2; ++n) *(f32x4*)(base + off + bj * HALF + n * 16) = acc[ai][bj][m][n] * scale; }
    }
};
struct EpiSoftmax : EpiBase {
    static constexpr bool PERM = false;
    bf16_t* P; LAS float* red; const LAS float* rowss; int ldc; float scale;
    __device__ __forceinline__ void operator()(const f32x4 (&acc_)[2][2][4][2], const Unit& u, int wr, int wc, int fr_, int fq) const {
        int fr = fr_; asm volatile("" : "+v"(fr));
        f32x4 (&acc)[2][2][4][2] = const_cast<f32x4 (&)[2][2][4][2]>(acc_);
        const float sc0 = scale * 1.4426950408889634f; bf16_t* base = P + zoff(u);
        const int col0 = u.pn * BM + wc * 32 + 4 * fq;
#pragma unroll
        for (int ai = 0; ai < 2; ++ai)
#pragma unroll
            for (int m = 0; m < 4; ++m) { float mx = -INFINITY; const float sc = rowss ? sc0 * rowss[u.idx * 256 + ai * HALF + wr * 64 + m * 16 + fr] : sc0;
#pragma unroll
                for (int bj = 0; bj < 2; ++bj)
#pragma unroll
                    for (int n = 0; n < 2; ++n) { f32x4 v = acc[ai][bj][m][n] * sc; acc[ai][bj][m][n] = v; mx = fmaxf(mx, fmaxf(fmaxf(v[0], v[1]), fmaxf(v[2], v[3]))); }
                mx = fmaxf(mx, __shfl_xor(mx, 16)); mx = fmaxf(mx, __shfl_xor(mx, 32));
                if (fq == 0) red[(ai * HALF + wr * 64 + m * 16 + fr) * 4 + wc] = mx; }
        asm volatile("s_waitcnt lgkmcnt(0)" ::: "memory"); __builtin_amdgcn_s_barrier(); asm volatile("" ::: "memory");
#pragma unroll
        for (int ai = 0; ai < 2; ++ai)
#pragma unroll
            for (int m = 0; m < 4; ++m) { const int r = ai * HALF + wr * 64 + m * 16 + fr; const f32x4 pm4 = *(const LAS f32x4*)(red + r * 4);
                const float rm = fmaxf(fmaxf(pm4[0], pm4[1]), fmaxf(pm4[2], pm4[3])); float sm = 0.f;
#pragma unroll
                for (int bj = 0; bj < 2; ++bj)
#pragma unroll
                    for (int n = 0; n < 2; ++n) { f32x4 v = acc[ai][bj][m][n];
#pragma unroll
                        for (int j = 0; j < 4; ++j) { v[j] = __builtin_amdgcn_exp2f(v[j] - rm); sm += v[j]; }
                        acc[ai][bj][m][n] = v; }
                sm += __shfl_xor(sm, 16); sm += __shfl_xor(sm, 32);
                if (fq == 0) red[1024 + r * 4 + wc] = sm; }
        asm volatile("s_waitcnt lgkmcnt(0)" ::: "memory"); __builtin_amdgcn_s_barrier(); asm volatile("" ::: "memory");
#pragma unroll
        for (int ai = 0; ai < 2; ++ai)
#pragma unroll
            for (int m = 0; m < 4; ++m) { const int r = ai * HALF + wr * 64 + m * 16 + fr; const f32x4 ps = *(const LAS f32x4*)(red + 1024 + r * 4);
                const float inv = 1.0f / ((ps[0] + ps[1]) + (ps[2] + ps[3]));
                bf16_t* rowp = base + (size_t)(u.pm * BM + r) * ldc + col0;
#pragma unroll
                for (int bj = 0; bj < 2; ++bj)
#pragma unroll
                    for (int n = 0; n < 2; ++n) { const f32x4 v = acc[ai][bj][m][n] * inv; u32x2 w; w.x = cvt_pk_bf16(v[0], v[1]); w.y = cvt_pk_bf16(v[2], v[3]); *(u32x2*)(rowp + bj * HALF + n * 16) = w; } }
    }
};
struct EpiGate3 : EpiBase {
    static constexpr bool PERM = true, HOOK = true; static constexpr int H1 = 16, H2 = 24;
    const bf16_t* Zg; const float* bg; bf16_t* XN;
    __device__ __forceinline__ static void ld8(float (&x)[8], const bf16_t* zp, const float* bp) {
        const u32x4 gz = *(const u32x4*)zp; const f32x4 b0 = *(const f32x4*)bp, b1 = *(const f32x4*)(bp + 4);
        x[0] = bflo(gz.x) + b0[0]; x[1] = bfhi(gz.x) + b0[1]; x[2] = bflo(gz.y) + b0[2]; x[3] = bfhi(gz.y) + b0[3]; x[4] = bflo(gz.z) + b1[0]; x[5] = bfhi(gz.z) + b1[1]; x[6] = bflo(gz.w) + b1[2]; x[7] = bfhi(gz.w) + b1[3];
    }
    __device__ __forceinline__ static void up8(float (&x)[8], const u32x4 gz, const f32x4 b0, const f32x4 b1) {
        x[0] = bflo(gz.x) + b0[0]; x[1] = bfhi(gz.x) + b0[1]; x[2] = bflo(gz.y) + b0[2]; x[3] = bfhi(gz.y) + b0[3]; x[4] = bflo(gz.z) + b1[0]; x[5] = bfhi(gz.z) + b1[1]; x[6] = bflo(gz.w) + b1[2]; x[7] = bfhi(gz.w) + b1[3];
    }
    __device__ __forceinline__ void hook(f32x4 (&acc)[2][2][4][2], const Unit& u, int seg, int wr, int wc, int fr_, int fq) const {
        int fr = fr_; asm volatile("" : "+v"(fr));
        const int col0 = u.pn * BM + wc * 32 + 8 * fq;
        f32x4 ba[2][2], bb[2][2];
#pragma unroll
        for (int bj = 0; bj < 2; ++bj) { const float* pa = bg + seg * D_ + col0 + bj * HALF; ba[bj][0] = *(const f32x4*)pa; ba[bj][1] = *(const f32x4*)(pa + 4); bb[bj][0] = *(const f32x4*)(pa + D_); bb[bj][1] = *(const f32x4*)(pa + D_ + 4); }
#pragma unroll
        for (int q = 0; q < 4; ++q) {
            const int ai = q >> 1, m0 = (q & 1) * 2;
            u32x4 za[2][2], zb[2][2];
#pragma unroll
            for (int mm = 0; mm < 2; ++mm)
#pragma unroll
                for (int bj = 0; bj < 2; ++bj) { const bf16_t* zp = Zg + (size_t)(u.pm * BM + ai * HALF + wr * 64 + (m0 + mm) * 16 + fr) * ZP + seg * D_ + col0 + bj * HALF; za[mm][bj] = *(const u32x4*)zp; zb[mm][bj] = *(const u32x4*)(zp + D_); }
#pragma unroll
            for (int mm = 0; mm < 2; ++mm)
#pragma unroll
                for (int bj = 0; bj < 2; ++bj) { float xa[8], xb[8]; up8(xa, za[mm][bj], ba[bj][0], ba[bj][1]); up8(xb, zb[mm][bj], bb[bj][0], bb[bj][1]);
#pragma unroll
                    for (int j = 0; j < 8; ++j) { const float ea = __builtin_amdgcn_exp2f(-1.4426950408889634f * xa[j]), eb = __builtin_amdgcn_exp2f(-1.4426950408889634f * xb[j]);
                        acc[ai][bj][m0 + mm][j >> 2][j & 3] *= (1.0f + eb) * __builtin_amdgcn_rcpf(1.0f + ea); } }
            __builtin_amdgcn_sched_barrier(0);
        }
    }
    __device__ __forceinline__ void operator()(const f32x4 (&acc)[2][2][4][2], const Unit& u, int wr, int wc, int fr, int fq) const {
        const int col0 = u.pn * BM + wc * 32 + 8 * fq;
#pragma unroll
        for (int ai = 0; ai < 2; ++ai)
#pragma unroll
            for (int m = 0; m < 4; ++m) { const size_t row = (size_t)(u.pm * BM + ai * HALF + wr * 64 + m * 16 + fr);
#pragma unroll
                for (int bj = 0; bj < 2; ++bj) { const int col = col0 + bj * HALF; float x[8], v[8];
                    ld8(x, Zg + row * ZP + 2 * D_ + col, bg + 2 * D_ + col);
#pragma unroll
                    for (int j = 0; j < 8; ++j) v[j] = acc[ai][bj][m][j >> 2][j & 3] * sigm(x[j]);
                    u32x4 w; w.x = cvt_pk_bf16(v[0], v[1]); w.y = cvt_pk_bf16(v[2], v[3]); w.z = cvt_pk_bf16(v[4], v[5]); w.w = cvt_pk_bf16(v[6], v[7]);
                    *(u32x4*)(XN + row * D_ + col) = w; } }
    }
};
struct EpiGate : EpiBase {
    static constexpr bool PERM = true;
    const bf16_t* Zg; const float* bg; float* MG; bf16_t* XN; int mode;
    __device__ __forceinline__ void operator()(const f32x4 (&acc)[2][2][4][2], const Unit& u, int wr, int wc, int fr, int fq) const {
        const int col0 = u.pn * BM + wc * 32 + 8 * fq;
#pragma unroll
        for (int ai = 0; ai < 2; ++ai)
#pragma unroll
            for (int m = 0; m < 4; ++m) { const size_t row = (size_t)(u.pm * BM + ai * HALF + wr * 64 + m * 16 + fr);
#pragma unroll
                for (int bj = 0; bj < 2; ++bj) { const int col = col0 + bj * HALF;
                    const u32x4 gz = *(const u32x4*)(Zg + row * ZP + col); const f32x4 bb0 = *(const f32x4*)(bg + col), bb1 = *(const f32x4*)(bg + col + 4);
                    float gp[8] = {bflo(gz.x) + bb0[0], bfhi(gz.x) + bb0[1], bflo(gz.y) + bb0[2], bfhi(gz.y) + bb0[3], bflo(gz.z) + bb1[0], bfhi(gz.z) + bb1[1], bflo(gz.w) + bb1[2], bfhi(gz.w) + bb1[3]};
                    float v[8];
#pragma unroll
                    for (int j = 0; j < 8; ++j) v[j] = acc[ai][bj][m][j >> 2][j & 3] * pg8::sigm(gp[j]);
                    u32x4* mp = (u32x4*)(XN + row * D_ + col);
                    if (mode != 0) { const u32x4 o = *mp; v[0] += bflo(o.x); v[1] += bfhi(o.x); v[2] += bflo(o.y); v[3] += bfhi(o.y); v[4] += bflo(o.z); v[5] += bfhi(o.z); v[6] += bflo(o.w); v[7] += bfhi(o.w); }
                    u32x4 w; w.x = cvt_pk_bf16(v[0], v[1]); w.y = cvt_pk_bf16(v[2], v[3]); w.z = cvt_pk_bf16(v[4], v[5]); w.w = cvt_pk_bf16(v[6], v[7]); *mp = w; }
                }
    }
};

template <class Epi>
__device__ __forceinline__ void gemm_phase(LAS unsigned char* lds, const Gemm g, const StaticOrder& S, const Epi& E) {
    const int tid = tid_opaque(), wid = __builtin_amdgcn_readfirstlane(tid >> 6), lane = tid & 63, wr = wid >> 2, wc = wid & 3, fr = lane & 15, fq = lane >> 4;
    const int K = g.K, nt = K / BK;
    unsigned voffA[2], voffB[2];
#pragma unroll
    for (int i = 0; i < 2; ++i) { int R, C; stage_rc(tid * 16 + i * 8192, R, C); const int Rb = Epi::PERM ? ((R & ~31) + perm32(R & 31)) : R;
        voffA[i] = (unsigned)(R * g.lda + C) * 2u; voffB[i] = (unsigned)(Rb * g.ldb + C) * 2u; }
    const size_t kstep = (size_t)(BK * 2);
    const size_t hstepA = (size_t)HALF * g.lda * 2, hstepB = (size_t)HALF * g.ldb * 2;
    const size_t tstepA = 2 * hstepA, tstepB = 2 * hstepB;
    const unsigned ldsw = (unsigned)wid * 1024u;
    const int aoff = lds_byte(wr * 64 + fr, fq * 8), boff = lds_byte(wc * 32 + fr, fq * 8);
#define PG8_SA(b, h) (((b) * 2 + (h)) * HTB)
#define PG8_SB(b, h) ((4 + (b) * 2 + (h)) * HTB)
#define PG8_STAGE(bufoff, gbase, voff) do { _Pragma("unroll") for (int _i = 0; _i < 2; ++_i) \
        __builtin_amdgcn_global_load_lds((const unsigned*)((const char*)(gbase) + (voff)[_i]), (LAS unsigned*)(lds + (bufoff) + ldsw + _i * 8192), 16, 0, 0); } while (0)
#define PG8_LDA(dst, b, h) do { _Pragma("unroll") for (int m = 0; m < 4; ++m) _Pragma("unroll") for (int k = 0; k < 2; ++k) dst[m][k] = *(const LAS bf16x8*)(lds + PG8_SA(b, h) + aoff + m * 2048 + k * 1024); } while (0)
#define PG8_LDB(dst, b, h) do { _Pragma("unroll") for (int n = 0; n < 2; ++n) _Pragma("unroll") for (int k = 0; k < 2; ++k) dst[n][k] = *(const LAS bf16x8*)(lds + PG8_SB(b, h) + boff + n * 2048 + k * 1024); } while (0)
#define PG8_MMA(ai, bj, At, Bt) do { __builtin_amdgcn_s_setprio(1); _Pragma("unroll") for (int m = 0; m < 4; ++m) _Pragma("unroll") for (int n = 0; n < 2; ++n) _Pragma("unroll") for (int k = 0; k < 2; ++k) \
        acc[ai][bj][m][n] = __builtin_amdgcn_mfma_f32_16x16x32_bf16(Bt[n][k], At[m][k], acc[ai][bj][m][n], 0, 0, 0); __builtin_amdgcn_s_setprio(0); } while (0)
#define PG8_WAIT_V(n) asm volatile("s_waitcnt vmcnt(" #n ")" ::: "memory")
#define PG8_WAIT_L(n) asm volatile("s_waitcnt lgkmcnt(" #n ")" ::: "memory")
#define PG8_BAR __builtin_amdgcn_s_barrier()
#define PG8_SCHED __builtin_amdgcn_sched_barrier(0)
    PG8_WAIT_V(0); PG8_WAIT_L(0); PG8_BAR;
    Unit cur, nxt; int ui = 0;
    if (!S.next(0, cur)) return;
    f32x4 acc[2][2][4][2];
#pragma unroll
    for (int a = 0; a < 2; ++a)
#pragma unroll
        for (int b = 0; b < 2; ++b)
#pragma unroll
            for (int m = 0; m < 4; ++m)
#pragma unroll
                for (int n = 0; n < 2; ++n) acc[a][b][m][n] = (f32x4){0.f, 0.f, 0.f, 0.f};
    bf16x8 At[4][2], B0[2][2], B1[2][2];
    const bf16_t* gA1 = g.A1; const bf16_t* gB1 = g.B1; const bf16_t* gA2 = g.A2; const bf16_t* gB2 = g.B2;
    asm volatile("" : "+s"(gA1), "+s"(gB1), "+s"(gA2), "+s"(gB2));
#define PG8_PA(u) ((const char*)((u).grp == 0 ? g.A + (long)((u).z / g.nzh) * g.sAb + (long)((u).z % g.nzh) * g.sAh : ((u).grp == 1 ? gA1 : gA2)) + (size_t)(u).pm * tstepA)
#define PG8_PB(u) ((const char*)((u).grp == 0 ? g.Bt + (long)((u).z / g.nzh) * g.sBb + (long)((u).z % g.nzh) * g.sBh : ((u).grp == 1 ? gB1 : gB2)) + (size_t)(u).pn * tstepB)
    const char* cA = PG8_PA(cur);
    const char* cB = PG8_PB(cur);
    PG8_STAGE(PG8_SB(0, 0), cB, voffB); PG8_STAGE(PG8_SB(0, 1), cB + hstepB, voffB); PG8_STAGE(PG8_SA(0, 0), cA, voffA); PG8_STAGE(PG8_SA(0, 1), cA + hstepA, voffA);
    if (wr == 1) PG8_BAR;
    PG8_WAIT_V(2); PG8_BAR;
    PG8_STAGE(PG8_SB(1, 0), cB + kstep, voffB); PG8_STAGE(PG8_SA(1, 0), cA + kstep, voffA); PG8_STAGE(PG8_SB(1, 1), cB + hstepB + kstep, voffB);
    PG8_WAIT_V(6); PG8_BAR;
    for (;;) {
        const bool has_next = S.next(ui + 1, nxt);
        const char* nA = has_next ? PG8_PA(nxt) : cA;
        const char* nB = has_next ? PG8_PB(nxt) : cB;
        for (int t = 0; t < nt; t += 2) {
            if constexpr (Epi::HOOK) { if (t == Epi::H1 || t == Epi::H2) E.hook(acc, cur, t == Epi::H1 ? 0 : 1, wr, wc, fr, fq); }
            const bool last = (t == nt - 2);
            const char* a1 = cA + (size_t)(t + 1) * kstep;
            const char* a2 = last ? nA : cA + (size_t)(t + 2) * kstep; const char* b2 = last ? nB : cB + (size_t)(t + 2) * kstep;
            const char* a3 = a2 + kstep; const char* b3 = b2 + kstep;
            PG8_LDB(B0, 0, 0); PG8_LDB(B1, 0, 1); PG8_SCHED; PG8_LDA(At, 0, 0); PG8_STAGE(PG8_SA(1, 1), a1 + hstepA, voffA);
            PG8_WAIT_V(8); PG8_WAIT_L(0); PG8_BAR; PG8_MMA(0, 0, At, B0); PG8_MMA(0, 1, At, B1); PG8_BAR; PG8_SCHED;
            PG8_LDA(At, 0, 1); PG8_STAGE(PG8_SB(0, 0), b2, voffB); PG8_STAGE(PG8_SB(0, 1), b2 + hstepB, voffB); PG8_STAGE(PG8_SA(0, 0), a2, voffA);
            PG8_WAIT_V(8); PG8_WAIT_L(0); PG8_BAR; PG8_MMA(1, 0, At, B0); PG8_MMA(1, 1, At, B1); PG8_BAR; PG8_SCHED;
            PG8_LDB(B0, 1, 0); PG8_LDB(B1, 1, 1); PG8_SCHED; PG8_LDA(At, 1, 0); PG8_STAGE(PG8_SA(0, 1), a2 + hstepA, voffA);
            PG8_WAIT_V(8); PG8_WAIT_L(0); PG8_BAR; PG8_MMA(0, 0, At, B0); PG8_MMA(0, 1, At, B1); PG8_BAR; PG8_SCHED;
            PG8_LDA(At, 1, 1); PG8_STAGE(PG8_SB(1, 0), b3, voffB); PG8_STAGE(PG8_SB(1, 1), b3 + hstepB, voffB); PG8_STAGE(PG8_SA(1, 0), a3, voffA);
            PG8_WAIT_V(8); PG8_WAIT_L(0); PG8_BAR; PG8_MMA(1, 0, At, B0); PG8_MMA(1, 1, At, B1); PG8_BAR; PG8_SCHED;
        }
        if (wr == 0) PG8_BAR;
        E(acc, cur, wr, wc, fr, fq);
        if (!has_next) break;
#pragma unroll
        for (int a = 0; a < 2; ++a)
#pragma unroll
            for (int b = 0; b < 2; ++b)
#pragma unroll
                for (int m = 0; m < 4; ++m)
#pragma unroll
                    for (int n = 0; n < 2; ++n) acc[a][b][m][n] = (f32x4){0.f, 0.f, 0.f, 0.f};
        cur = nxt; cA = nA; cB = nB; ++ui;
        if (wr == 1) PG8_BAR;
    }
    PG8_WAIT_V(0);
    PG8_BAR;
#undef PG8_PA
#undef PG8_PB
#undef PG8_SA
#undef PG8_SB
#undef PG8_STAGE
#undef PG8_LDA
#undef PG8_LDB
#undef PG8_MMA
#undef PG8_WAIT_V
#undef PG8_WAIT_L
#undef PG8_BAR
#undef PG8_SCHED
}
}

#define XB_TMO      128
#define XB_XCNT(j)  (256  + 64 * (j))
#define XB_XSUB(j)  (1280 + 64 * (j))
#define XB_XGEN(j)  (2304 + 64 * (j))
#define XB_TOP      3328
#define XB_TOPGEN   3392
#define XCD_BAR_WORDS 3456
#define XB_SPIN_CAP (1u << 18)
__device__ __forceinline__ unsigned xb_ld(unsigned* p)              { return __hip_atomic_load(p, __ATOMIC_RELAXED, __HIP_MEMORY_SCOPE_AGENT); }
__device__ __forceinline__ unsigned xb_add(unsigned* p, unsigned v) { return __hip_atomic_fetch_add(p, v, __ATOMIC_RELAXED, __HIP_MEMORY_SCOPE_AGENT); }
__device__ __forceinline__ unsigned xb_xcc_id() { return (unsigned)__builtin_amdgcn_s_getreg((3 << 11) | 20) & 0xFu; }
#define XB_SPIN(cond, bar) do { unsigned _sp = 0; while (cond) { __builtin_amdgcn_s_sleep(1); \
    if ((++_sp & 255u) == 0u) { if (xb_ld(&(bar)[XB_TMO])) break; if (_sp > XB_SPIN_CAP) { atomicAdd(&(bar)[XB_TMO], 1u); break; } } } } while (0)
struct XcdBarrier { unsigned* bar; unsigned x; volatile LAS unsigned* st; };
__device__ __forceinline__ XcdBarrier xcd_barrier_post(unsigned* bar, volatile LAS unsigned* st) {
    XcdBarrier b; b.bar = bar; b.x = xb_xcc_id(); b.st = st;
    if (threadIdx.x == 0) (void)xb_add(&bar[XB_XCNT(b.x)], 1u);
    return b;
}
__device__ __forceinline__ void xcd_barrier_complete(unsigned* bar, unsigned x, unsigned& nloc, unsigned& nx) {
    const unsigned G = gridDim.x * gridDim.y * gridDim.z;
    unsigned sum, cnt, mine, sp = 0u;
    for (;;) {
        sum = 0u; cnt = 0u; mine = 0u;
#pragma unroll
        for (unsigned j = 0; j < 16; ++j) { const unsigned c = xb_ld(&bar[XB_XCNT(j)]); sum += c; cnt += (c > 0u) ? 1u : 0u; mine = (j == x) ? c : mine; }
        if (sum == G) break;
        __builtin_amdgcn_s_sleep(1);
        if ((++sp & 255u) == 0u) { if (xb_ld(&bar[XB_TMO])) break; if (sp > XB_SPIN_CAP) { atomicAdd(&bar[XB_TMO], 1u); break; } }
    }
    nloc = mine > 0u ? mine : 1u; nx = cnt > 0u ? cnt : 1u;
}
__device__ __forceinline__ void xcd_barrier(const XcdBarrier& b) {
    asm volatile("s_waitcnt vmcnt(0)" ::: "memory");
    __syncthreads();
    if (threadIdx.x == 0) {
        unsigned* bar = b.bar;
        __builtin_amdgcn_s_waitcnt(0);
        unsigned nloc = b.st[0], nx = b.st[1];
        if (nloc == 0u) { xcd_barrier_complete(bar, b.x, nloc, nx); b.st[0] = nloc; b.st[1] = nx; }
        const unsigned old = xb_add(&bar[XB_XSUB(b.x)], 1u);
        const unsigned gen = old / nloc;
        if (old + 1u == (gen + 1u) * nloc) {
            __builtin_amdgcn_fence(__ATOMIC_RELEASE, "agent");
            asm volatile("s_waitcnt vmcnt(0)" ::: "memory");
            const unsigned og = xb_add(&bar[XB_TOP], 1u);
            const unsigned tg = og / nx;
            if (og + 1u == (tg + 1u) * nx) xb_add(&bar[XB_TOPGEN], 1u);
            else XB_SPIN(xb_ld(&bar[XB_TOPGEN]) == tg, bar);
            __builtin_amdgcn_fence(__ATOMIC_ACQUIRE, "agent");
            xb_add(&bar[XB_XGEN(b.x)], 1u);
            asm volatile("s_waitcnt vmcnt(0)" ::: "memory");
        } else {
            XB_SPIN(xb_ld(&bar[XB_XGEN(b.x)]) == gen, bar);
            __builtin_amdgcn_fence(__ATOMIC_ACQUIRE, "agent");
            asm volatile("s_waitcnt vmcnt(0)" ::: "memory");
        }
    }
    __syncthreads();
}

struct Args { const float* in[29]; float* out; unsigned char* ws; int lo, hi; };
enum { I_X = 0, I_MEM, I_F1N, I_F1I, I_F1O, I_MIXN, I_WIN, I_BGATE, I_QN, I_KVN, I_WUQ, I_WUKV, I_WPM, I_WA2, I_BA, I_GLAN, I_WPG, I_CONVW, I_WPC, I_WMO,
       I_XN, I_MEMN, I_WXQ, I_WXKV, I_WXO, I_F2N, I_F2I, I_F2O, I_FINN };

__device__ __forceinline__ void transpose_job(const float* W, int ldw, int c0, int ncols, int ncpad, int K, bf16_t* WT, int ldk, int koff, int mode, int p0, const float* gk,
                                              LAS float* scr, int gw, int NGW, int lane) {
    const int nblk = ncpad / 32, items = (K / 64) * nblk;
    for (int item = gw; item < items; item += NGW) {
        const int kb = item / nblk, nb = item % nblk, k0 = 64 * kb, n0 = 32 * nb;
        int r0;
        if (mode == 0) r0 = n0;
        else if (mode == 1) { const int half = n0 >= F_ ? 1 : 0; const int n1 = n0 - half * F_; r0 = 256 * (n1 / 128) + half * 128 + (n1 % 128); }
        else { const int grp = n0 / 256, within = n0 % 256; r0 = (within / 128 == p0) ? grp * 128 + (within % 128) : -1; }
        if (r0 < 0) continue;
        const int nn = n0 + (lane & 31); const bool ok = nn < ncols;
        float tv[32];
        const float* wp = W + (size_t)(k0 + (lane >> 5)) * ldw + c0 + (ok ? nn : 0);
#pragma unroll
        for (int i = 0; i < 32; ++i) tv[i] = wp[(size_t)(2 * i) * ldw];
#pragma unroll
        for (int i = 0; i < 32; ++i) { const int kk = 2 * i + (lane >> 5); scr[kk * 33 + (lane & 31)] = ok ? tv[i] : 0.f; }
        asm volatile("s_waitcnt lgkmcnt(0)" ::: "memory");
        const int c = lane & 7;
        f32x4 ga = (f32x4){1.f, 1.f, 1.f, 1.f}, gb = ga;
        if (gk) { ga = *(const f32x4*)(gk + k0 + 8 * c); gb = *(const f32x4*)(gk + k0 + 8 * c + 4); }
#pragma unroll
        for (int j = 0; j < 4; ++j) { const int n = (lane >> 3) + 8 * j; const LAS float* s = scr + (8 * c) * 33 + n;
            u32x4 o; o.x = cvt_pk_bf16(s[0 * 33] * ga[0], s[1 * 33] * ga[1]); o.y = cvt_pk_bf16(s[2 * 33] * ga[2], s[3 * 33] * ga[3]); o.z = cvt_pk_bf16(s[4 * 33] * gb[0], s[5 * 33] * gb[1]); o.w = cvt_pk_bf16(s[6 * 33] * gb[2], s[7 * 33] * gb[3]);
            *(u32x4*)(WT + (size_t)(r0 + n) * ldk + koff + k0 + 8 * c) = o; }
        asm volatile("s_waitcnt lgkmcnt(0)" ::: "memory");
    }
}

__device__ __forceinline__ void convert_job(const Args& a, int l, int j, LAS float* scr, int gw, int NGW, int lane) {
    unsigned char* ws = a.ws;
                const float* W; const float* gk = nullptr; int ldw, c0 = 0, ncols, ncpad, K, mode = 0, p0 = 0, ldk = 0, koff = 0; size_t dst;
                switch (j) {
                case 0: W = a.in[I_F1I] + (size_t)l * D_ * 2 * F_; ldw = 2 * F_; ncols = 2 * F_; K = D_; dst = WS_W1I; mode = 1; gk = a.in[I_F1N] + l * D_; break;
                case 1: W = a.in[I_F1O] + (size_t)l * F_ * D_; ldw = D_; ncols = D_; K = F_; dst = WS_W1O; break;
                case 2: W = a.in[I_WIN] + (size_t)l * D_ * NZIN; ldw = NZIN; ncols = NZIN; K = D_; dst = WS_WIN; gk = a.in[I_MIXN] + l * D_; break;
                case 3: W = a.in[I_WUQ] + (size_t)l * 512 * 1536; ldw = 1536; ncols = 1536; K = 512; dst = WS_WUQ; break;
                case 4: W = a.in[I_WUKV] + (size_t)l * 512 * 2048; ldw = 2048; ncols = 2048; K = 512; dst = WS_WUK; mode = 2; p0 = 0; break;
                case 5: W = a.in[I_WUKV] + (size_t)l * 512 * 2048; ldw = 2048; ncols = 2048; K = 512; dst = WS_WUV; mode = 2; p0 = 1; break;
                case 6: W = a.in[I_WPM] + (size_t)l * 1024 * 2048; ldw = 2048; ncols = 2048; K = 1024; dst = WS_WPM; ldk = 2048; koff = 0; break;
                case 7: W = a.in[I_WPG] + (size_t)l * 512 * 2048; ldw = 2048; ncols = 2048; K = 512; dst = WS_WPM; ldk = 2048; koff = 1024; break;
                case 8: W = a.in[I_WPC] + (size_t)l * 512 * 2048; ldw = 2048; ncols = 2048; K = 512; dst = WS_WPM; ldk = 2048; koff = 1536; break;
                case 9: W = a.in[I_WMO] + (size_t)l * 2048 * 2048; ldw = 2048; ncols = 2048; K = 2048; dst = WS_WMO; break;
                case 10: {
                    const float* Wq = a.in[I_WXQ] + (size_t)l * 2048 * 2048; const float* gq = a.in[I_XN] + l * D_; bf16_t* dq = (bf16_t*)(ws + WS_WXQ);
                    for (int c8 = gw * 64 + lane; c8 < 2048 * 256; c8 += NGW * 64) { const int row = c8 >> 8; const float gg = gq[row];
                        const f32x4 x0 = *(const f32x4*)(Wq + (size_t)c8 * 8), x1 = *(const f32x4*)(Wq + (size_t)c8 * 8 + 4);
                        u32x4 o; o.x = cvt_pk_bf16(x0[0] * gg, x0[1] * gg); o.y = cvt_pk_bf16(x0[2] * gg, x0[3] * gg); o.z = cvt_pk_bf16(x1[0] * gg, x1[1] * gg); o.w = cvt_pk_bf16(x1[2] * gg, x1[3] * gg);
                        *(u32x4*)(dq + (size_t)c8 * 8) = o; }
                    return; }
                case 11: W = a.in[I_WXKV] + (size_t)l * 2048 * 4096; ldw = 4096; ncols = 2048; K = 2048; dst = WS_WXK; break;
                case 12: W = a.in[I_WXKV] + (size_t)l * 2048 * 4096; ldw = 4096; c0 = 2048; ncols = 2048; K = 2048; dst = WS_WXV; break;
                case 13: W = a.in[I_WXO] + (size_t)l * 2048 * 2048; ldw = 2048; ncols = 2048; K = 2048; dst = WS_WXO; break;
                case 14: W = a.in[I_F2I] + (size_t)l * D_ * 2 * F_; ldw = 2 * F_; ncols = 2 * F_; K = D_; dst = WS_W2I; mode = 1; gk = a.in[I_F2N] + l * D_; break;
                default: W = a.in[I_F2O] + (size_t)l * F_ * D_; ldw = D_; ncols = D_; K = F_; dst = WS_W2O; break;
                }
                ncpad = (j == 2) ? ZP : ncols;
                transpose_job(W, ldw, c0, ncols, ncpad, K, (bf16_t*)(ws + dst), ldk ? ldk : K, koff, mode, p0, gk, scr, gw, NGW, lane);
            }
__device__ __forceinline__ void rms_row_bf16(const float* xrow, const float* g, bf16_t* orow, int lane) {
    const f32x4* xr = (const f32x4*)xrow + lane; const f32x4* gr = (const f32x4*)g + lane;
    f32x4 v[8]; float s = 0.f;
#pragma unroll
    for (int j = 0; j < 8; ++j) { v[j] = xr[64 * j]; s += (v[j][0] * v[j][0] + v[j][1] * v[j][1]) + (v[j][2] * v[j][2] + v[j][3] * v[j][3]); }
    const float rstd = 1.0f / sqrtf(wave_sum(s) * (1.0f / 2048.0f) + EPS_);
    u32x2* o8 = (u32x2*)orow + lane;
#pragma unroll
    for (int j = 0; j < 8; ++j) { const f32x4 gg = gr[64 * j]; u32x2 w; w.x = cvt_pk_bf16(v[j][0] * rstd * gg[0], v[j][1] * rstd * gg[1]); w.y = cvt_pk_bf16(v[j][2] * rstd * gg[2], v[j][3] * rstd * gg[3]); o8[64 * j] = w; }
}
__device__ __forceinline__ void rms_row_f32(float* xrow, const float* g, int lane) {
    f32x4* xr = (f32x4*)xrow + lane; const f32x4* gr = (const f32x4*)g + lane;
    f32x4 v[8]; float s = 0.f;
#pragma unroll
    for (int j = 0; j < 8; ++j) { v[j] = xr[64 * j]; s += (v[j][0] * v[j][0] + v[j][1] * v[j][1]) + (v[j][2] * v[j][2] + v[j][3] * v[j][3]); }
    const float rstd = 1.0f / sqrtf(wave_sum(s) * (1.0f / 2048.0f) + EPS_);
#pragma unroll
    for (int j = 0; j < 8; ++j) { const f32x4 gg = gr[64 * j]; xr[64 * j] = v[j] * rstd * gg; }
}

__device__ __forceinline__ void mixer_row(const Args& a, int l, int t, int lane) {
    unsigned char* ws = a.ws;
    const bf16_t* Z = (const bf16_t*)(ws + WS_Z); const bf16_t* zr = Z + (size_t)t * ZP;
#pragma unroll
    for (int which = 0; which < 2; ++which) {
        const u32x4 w = *(const u32x4*)(zr + (which ? OFF_CKV : OFF_CQ) + lane * 8);
        float x[8] = {bflo(w.x), bfhi(w.x), bflo(w.y), bfhi(w.y), bflo(w.z), bfhi(w.z), bflo(w.w), bfhi(w.w)};
        float s = 0.f;
#pragma unroll
        for (int j = 0; j < 8; ++j) s += x[j] * x[j];
        const float rstd = 1.0f / sqrtf(wave_sum(s) * (1.0f / 512.0f) + EPS_);
        const float* g = a.in[which ? I_KVN : I_QN] + l * 512 + lane * 8;
        u32x4 o; o.x = cvt_pk_bf16(x[0] * rstd * g[0], x[1] * rstd * g[1]); o.y = cvt_pk_bf16(x[2] * rstd * g[2], x[3] * rstd * g[3]);
        o.z = cvt_pk_bf16(x[4] * rstd * g[4], x[5] * rstd * g[5]); o.w = cvt_pk_bf16(x[6] * rstd * g[6], x[7] * rstd * g[7]);
        *(u32x4*)((bf16_t*)(ws + (which ? WS_CKVN : WS_CQN)) + (size_t)t * 512 + lane * 8) = o;
    }
    {
        const int i = lane & 31, pos = t & (S_ - 1);
        const float x1 = bf2f(zr[OFF_KR + i]), x2 = bf2f(zr[OFF_KR + 32 + i]);
        const f32x2 cs = ((const f32x2*)(ws + WS_CS))[pos * 32 + i];
        const float o = (lane < 32) ? (x1 * cs.x - x2 * cs.y) : (x2 * cs.x + x1 * cs.y);
        ((bf16_t*)(ws + WS_KPE))[(size_t)t * 64 + lane] = (bf16_t)(cvt_pk_bf16(o, 0.f) & 0xffffu);
    }
    {
        const int pos = t & (S_ - 1); const int c = lane * 8;
        const float* cw = a.in[I_CONVW] + l * 1536 + c;
        float accv[8] = {0.f, 0.f, 0.f, 0.f, 0.f, 0.f, 0.f, 0.f};
#pragma unroll
        for (int w = 0; w < 3; ++w) {
            const int dt = 2 - w;
            if (pos - dt >= 0) {
                const bf16_t* zz = zr - (size_t)dt * ZP + OFF_CV;
                const u32x4 cg_ = *(const u32x4*)(zz + 512 + c), hh = *(const u32x4*)(zz + 1024 + c);
                const float cgv[8] = {bflo(cg_.x), bfhi(cg_.x), bflo(cg_.y), bfhi(cg_.y), bflo(cg_.z), bfhi(cg_.z), bflo(cg_.w), bfhi(cg_.w)};
                const float hv[8] = {bflo(hh.x), bfhi(hh.x), bflo(hh.y), bfhi(hh.y), bflo(hh.z), bfhi(hh.z), bflo(hh.w), bfhi(hh.w)};
#pragma unroll
                for (int j = 0; j < 8; ++j) accv[j] += cw[w * 512 + j] * (cgv[j] * hv[j]);
            }
        }
        const u32x4 bgw = *(const u32x4*)(zr + OFF_CV + c);
        const float bv[8] = {bflo(bgw.x), bfhi(bgw.x), bflo(bgw.y), bfhi(bgw.y), bflo(bgw.z), bfhi(bgw.z), bflo(bgw.w), bfhi(bgw.w)};
        u32x4 o; o.x = cvt_pk_bf16(bv[0] * accv[0], bv[1] * accv[1]); o.y = cvt_pk_bf16(bv[2] * accv[2], bv[3] * accv[3]);
        o.z = cvt_pk_bf16(bv[4] * accv[4], bv[5] * accv[5]); o.w = cvt_pk_bf16(bv[6] * accv[6], bv[7] * accv[7]);
        *(u32x4*)((bf16_t*)(ws + WS_ACT) + (size_t)t * 2048 + 1536 + c) = o;
    }
}

template <int NC>
__device__ __forceinline__ void lds_mm(float (&acc)[4][NC], const LAS float* Ap, int sAr, int sAk, const LAS float* Bp, int sBk, int sBc, int ty, int tx) {
    f32x2 acc2[4][NC / 2];
#pragma unroll
    for (int i = 0; i < 4; ++i)
#pragma unroll
        for (int j = 0; j < NC / 2; ++j) acc2[i][j] = (f32x2){0.f, 0.f};
#pragma unroll 8
    for (int k = 0; k < 64; ++k) {
        float av[4]; f32x2 bv[NC / 2];
#pragma unroll
        for (int i = 0; i < 4; ++i) av[i] = Ap[(4 * ty + i) * sAr + k * sAk];
#pragma unroll
        for (int j = 0; j < NC / 2; ++j) { bv[j].x = Bp[k * sBk + (tx + 64 * j) * sBc]; bv[j].y = Bp[k * sBk + (tx + 64 * j + 32) * sBc]; }
#pragma unroll
        for (int i = 0; i < 4; ++i)
#pragma unroll
            for (int j = 0; j < NC / 2; ++j) acc2[i][j] += bv[j] * av[i];
    }
#pragma unroll
    for (int i = 0; i < 4; ++i)
#pragma unroll
        for (int j = 0; j < NC / 2; ++j) { acc[i][2 * j] = acc2[i][j].x; acc[i][2 * j + 1] = acc2[i][j].y; }
}
__device__ __forceinline__ f32x16 lds_mm32(const LAS float* Ap, int sAr, int sAk, const LAS float* Bp, int sBk, int sBc, int rb, int cb, int r32, int hi) {
    f32x16 c;
#pragma unroll
    for (int r = 0; r < 16; ++r) c[r] = 0.f;
    const LAS float* ap = Ap + (rb * 32 + r32) * sAr + hi * sAk; const LAS float* bp = Bp + hi * sBk + (cb * 32 + r32) * sBc;
#pragma unroll 8
    for (int st = 0; st < 32; ++st) c = __builtin_amdgcn_mfma_f32_32x32x2f32(ap[2 * st * sAk], bp[2 * st * sBk], c, 0, 0, 0);
    return c;
}
__device__ __forceinline__ int grow(int r, int hi) { return (r & 3) + 8 * (r >> 2) + 4 * hi; }
constexpr int GP = 65;
__device__ __forceinline__ void gla_p1(const Args& a, int l, int unit, LAS float* L) {
    unsigned char* ws = a.ws; const int tid = tid_opaque();
    const int n = unit & 63, h = (unit >> 6) & 3, b = unit >> 8;
    const int t0 = b * S_ + n * 64;
    const bf16_t* Z = (const bf16_t*)(ws + WS_Z);
    LAS float* qs = L; LAS float* ks = qs + 64 * GP; LAS float* kd = ks + 64 * GP; LAS float* bc = kd + 64 * GP; LAS float* Am = bc + 64 * GP;
    LAS float* vs = Am + 64 * GP; LAS float* al = vs + 64 * 128;
    __syncthreads();
    {
        const int t = tid >> 3, part = tid & 7; const bf16_t* zr = Z + (size_t)(t0 + t) * ZP;
        const u32x4 wq = *(const u32x4*)(zr + OFF_GQ + h * 64 + part * 8), wk = *(const u32x4*)(zr + OFF_GK + h * 64 + part * 8);
        const u32x4 wv0 = *(const u32x4*)(zr + OFF_GV + h * 128 + part * 8), wv1 = *(const u32x4*)(zr + OFF_GV + h * 128 + 64 + part * 8);
        u32x4 wa = (u32x4){0u, 0u, 0u, 0u}; if (part < 2) wa = *(const u32x4*)(zr + OFF_AL + part * 8);
#define GLA_UNPK(dst, VV) do { (dst)[0] = bflo((VV).x); (dst)[1] = bfhi((VV).x); (dst)[2] = bflo((VV).y); (dst)[3] = bfhi((VV).y); (dst)[4] = bflo((VV).z); (dst)[5] = bfhi((VV).z); (dst)[6] = bflo((VV).w); (dst)[7] = bfhi((VV).w); } while (0)
        LAS float* q_ = qs + t * GP + part * 8; LAS float* k_ = ks + t * GP + part * 8; LAS float* v0_ = vs + t * 128 + part * 8; LAS float* v1_ = v0_ + 64;
        GLA_UNPK(q_, wq); GLA_UNPK(k_, wk); GLA_UNPK(v0_, wv0); GLA_UNPK(v1_, wv1);
        if (part < 2) { LAS float* a_ = al + t * 16 + part * 8; GLA_UNPK(a_, wa); }
#undef GLA_UNPK
    }
    __syncthreads();
    {
        const int j = tid & 63, tg = tid >> 6;
        const float* w2 = a.in[I_WA2] + l * 4096 + h * 64 + j; float w[16];
#pragma unroll
        for (int i = 0; i < 16; ++i) w[i] = w2[i * 256];
        const float bias = a.in[I_BA][l * 256 + h * 64 + j];
#pragma unroll
        for (int tt = 0; tt < 8; ++tt) { const int t = tg * 8 + tt; float x = bias;
#pragma unroll
            for (int i = 0; i < 16; ++i) x += al[t * 16 + i] * w[i];
            bc[t * GP + j] = (fminf(x, 0.f) - log1pf(__expf(-fabsf(x)))) * (1.0f / 16.0f); }
    }
    __syncthreads();
    if (tid < 64) { float run = 0.f;
#pragma unroll 8
        for (int t = 0; t < 64; ++t) { run += bc[t * GP + tid]; bc[t * GP + tid] = run; } }
    __syncthreads();
    float* QD = (float*)(ws + WS_QD);
    for (int e = tid; e < 64 * 64; e += NTHR) { const int t = e >> 6, d = e & 63; const float bb = bc[t * GP + d], bl = bc[63 * GP + d];
        const float q = qs[t * GP + d] * 0.125f * __expf(bb), k = ks[t * GP + d];
        qs[t * GP + d] = q; QD[(size_t)(t0 + t) * 256 + h * 64 + d] = q;
        ks[t * GP + d] = k * __expf(-bb); kd[t * GP + d] = k * __expf(bl - bb); }
    if (tid < 64) ((float*)(ws + WS_CD))[(size_t)((b * 4 + h) * 64 + n) * 64 + tid] = __expf(bc[63 * GP + tid]);
    __syncthreads();
    const int wid = tid >> 6, lane = tid & 63, r32 = lane & 31, hi = lane >> 5;
    if (wid < 4) {
        const int rb = wid >> 1, cb = wid & 1; const f32x16 c = lds_mm32(qs, GP, 1, ks, 1, GP, rb, cb, r32, hi);
#pragma unroll
        for (int r = 0; r < 16; ++r) { const int t = rb * 32 + grow(r, hi), sx = cb * 32 + r32; Am[t * GP + sx] = (sx <= t) ? c[r] : 0.f; }
    }
    __syncthreads();
    const int rb = wid >> 2, cb = wid & 3;
    {
        const f32x16 c = lds_mm32(Am, GP, 1, vs, 128, 1, rb, cb, r32, hi);
        float* OI = (float*)(ws + WS_OI) + (size_t)(t0 + rb * 32) * 512 + h * 128 + cb * 32 + r32;
#pragma unroll
        for (int r = 0; r < 16; ++r) OI[(size_t)grow(r, hi) * 512] = c[r];
    }
    {
        const f32x16 c = lds_mm32(kd, 1, GP, vs, 128, 1, rb, cb, r32, hi);
        float* KV = (float*)(ws + WS_KV) + (size_t)((b * 4 + h) * 64 + n) * 8192 + (rb * 32) * 128 + cb * 32 + r32;
#pragma unroll
        for (int r = 0; r < 16; ++r) KV[grow(r, hi) * 128] = c[r];
    }
}
__device__ __forceinline__ void gla_p2(const Args& a, int blk) {
    unsigned char* ws = a.ws; const int tid = tid_opaque();
    if (tid >= 256) return;
    const int bh = blk >> 5, e = (blk & 31) * 256 + tid, d = e >> 7;
    const float* __restrict__ KV = (const float*)(ws + WS_KV) + (size_t)bh * 64 * 8192 + e;
    float* __restrict__ ST = (float*)(ws + WS_ST) + (size_t)bh * 64 * 8192 + e;
    const float* __restrict__ CD = (const float*)(ws + WS_CD) + (size_t)bh * 64 * 64 + d;
    float st = 0.f;
#pragma unroll 8
    for (int n = 0; n < 64; ++n) { const float kv = KV[(size_t)n * 8192], cd = CD[n * 64]; ST[(size_t)n * 8192] = st; st = cd * st + kv; }
}
__device__ __forceinline__ void gla_p3(const Args& a, int l, int unit, LAS float* L) {
    unsigned char* ws = a.ws; const int tid = tid_opaque();
    const int n = unit & 63, h = (unit >> 6) & 3, b = unit >> 8;
    const int t0 = b * S_ + n * 64;
    LAS float* qs = L; LAS float* ss = qs + 64 * GP;
    __syncthreads();
    const float* QD = (const float*)(ws + WS_QD);
    const float* ST = (const float*)(ws + WS_ST) + (size_t)((b * 4 + h) * 64 + n) * 8192;
    {
        f32x4 qv[2], sv[4];
#pragma unroll
        for (int i = 0; i < 2; ++i) { const int c = tid + i * NTHR, t = c >> 4, part = c & 15; qv[i] = *(const f32x4*)(QD + (size_t)(t0 + t) * 256 + h * 64 + part * 4); }
#pragma unroll
        for (int i = 0; i < 4; ++i) sv[i] = *((const f32x4*)ST + tid + i * NTHR);
#pragma unroll
        for (int i = 0; i < 2; ++i) { const int c = tid + i * NTHR, t = c >> 4, part = c & 15; LAS float* q_ = qs + t * GP + part * 4; q_[0] = qv[i][0]; q_[1] = qv[i][1]; q_[2] = qv[i][2]; q_[3] = qv[i][3]; }
#pragma unroll
        for (int i = 0; i < 4; ++i) *((LAS f32x4*)ss + tid + i * NTHR) = sv[i];
    }
    __syncthreads();
    const int wid = tid >> 6, lane = tid & 63, r32 = lane & 31, hi = lane >> 5, rb = wid >> 2, cb = wid & 3;
    f32x16 c = lds_mm32(qs, GP, 1, ss, 128, 1, rb, cb, r32, hi);
    const float* OI = (const float*)(ws + WS_OI) + (size_t)(t0 + rb * 32) * 512 + h * 128 + cb * 32 + r32;
    LAS float* red = ss + 8192;
#pragma unroll
    for (int r = 0; r < 16; ++r) { c[r] += OI[(size_t)grow(r, hi) * 512]; float q = c[r] * c[r];
#pragma unroll
        for (int o = 1; o < 32; o <<= 1) q += __shfl_xor(q, o);
        if (r32 == 0) red[(rb * 32 + grow(r, hi)) * 4 + cb] = q; }
    __syncthreads();
    const bf16_t* Z = (const bf16_t*)(ws + WS_Z); bf16_t* OG = (bf16_t*)(ws + WS_ACT);
    const float gn = a.in[I_GLAN][l * 512 + h * 128 + cb * 32 + r32];
#pragma unroll
    for (int r = 0; r < 16; ++r) { const int tl = rb * 32 + grow(r, hi); const f32x4 pq = *(const LAS f32x4*)(red + tl * 4);
        const float rstd = 1.0f / sqrtf(((pq[0] + pq[1]) + (pq[2] + pq[3])) * (1.0f / 128.0f) + EPS_);
        const size_t t = (size_t)(t0 + tl); const float rg = bf2f(Z[t * ZP + OFF_GR + h * 128 + cb * 32 + r32]);
        const float o = c[r] * rstd * gn * (rg * pg8::sigm(rg));
        OG[t * 2048 + 1024 + h * 128 + cb * 32 + r32] = (bf16_t)(cvt_pk_bf16(o, 0.f) & 0xffffu); }
}

constexpr int KPITCH = 400, VPITCH = 144, KSLOT = 64 * KPITCH, VSLOT = 128 * VPITCH;
__device__ __forceinline__ int crow(int r, int hi) { return (r & 3) + 8 * (r >> 2) + 4 * hi; }
__device__ __forceinline__ void mla_unit(const Args& a, int b, int h, int qb, LAS unsigned char* lds) {
    unsigned char* ws = a.ws;
    const int tid = tid_opaque(), lane = tid & 63, wid = __builtin_amdgcn_readfirstlane(tid >> 6), wq = wid & 3, grp = wid >> 2, r32 = lane & 31, hi = lane >> 5;
    const bf16_t* Qb = (const bf16_t*)(ws + WS_QB); const bf16_t* Kn = (const bf16_t*)(ws + WS_KN); const bf16_t* Kpe = (const bf16_t*)(ws + WS_KPE);
    const bf16_t* VT = (const bf16_t*)(ws + WS_VT); bf16_t* OM = (bf16_t*)(ws + WS_ACT);
    LAS unsigned char* Kl = lds; LAS unsigned char* Vl = lds + 2 * KSLOT;
    const int pos = qb * 128 + wq * 32 + r32; const size_t qrow = (size_t)b * S_ + pos;
    bf16x8 qf[12];
    {
        const bf16_t* qp = Qb + qrow * 1536 + h * 192;
#pragma unroll
        for (int d0 = 0; d0 < 8; ++d0) qf[d0] = *(const bf16x8*)(qp + 16 * d0 + 8 * hi);
        const f32x2* cs = (const f32x2*)(ws + WS_CS) + pos * 32;
#pragma unroll
        for (int d0 = 8; d0 < 12; ++d0) {
            const int i0 = 16 * (d0 - 8) + 8 * hi, ib = i0 & 31;
            const u32x4 w1 = *(const u32x4*)(qp + 128 + ib), w2 = *(const u32x4*)(qp + 160 + ib);
            const float x1[8] = {bflo(w1.x), bfhi(w1.x), bflo(w1.y), bfhi(w1.y), bflo(w1.z), bfhi(w1.z), bflo(w1.w), bfhi(w1.w)};
            const float x2[8] = {bflo(w2.x), bfhi(w2.x), bflo(w2.y), bfhi(w2.y), bflo(w2.z), bfhi(w2.z), bflo(w2.w), bfhi(w2.w)};
            float o[8];
#pragma unroll
            for (int j = 0; j < 8; ++j) { const f32x2 c = cs[ib + j]; o[j] = (i0 < 32) ? (x1[j] * c.x - x2[j] * c.y) : (x2[j] * c.x + x1[j] * c.y); }
            u32x4 w; w.x = cvt_pk_bf16(o[0], o[1]); w.y = cvt_pk_bf16(o[2], o[3]); w.z = cvt_pk_bf16(o[4], o[5]); w.w = cvt_pk_bf16(o[6], o[7]);
            qf[d0] = __builtin_bit_cast(bf16x8, w);
        }
    }
    float mrun = -1e30f, lsum = 0.f;
    f32x16 oT[4];
#pragma unroll
    for (int i = 0; i < 4; ++i)
#pragma unroll
        for (int r = 0; r < 16; ++r) oT[i][r] = 0.f;
    const float SC = 0.07216878364870322f * 1.4426950408889634f;
    const int npairs = qb + 1;
    u32x4 pf[10];
    const unsigned rb0 = (unsigned)b * S_;
#define MLA_KROW(k) (((k) & ~12u) | (((k) & 4u) << 1) | (((k) & 8u) >> 1))
#define MLA_MAP() unsigned gsrc[5], ldst[5]; { int t2 = tid; asm volatile("" : "+v"(t2)); \
        _Pragma("unroll") for (int i = 0; i < 2; ++i) { const unsigned cc = t2 + i * NTHR, key = cc >> 4, part = cc & 15; gsrc[i] = (unsigned)WS_KN + ((rb0 + key) * 1024 + h * 128 + part * 8) * 2; ldst[i] = MLA_KROW(key) * KPITCH + part * 16; } \
        { const unsigned key = t2 >> 3, part = t2 & 7; gsrc[2] = (unsigned)WS_KPE + ((rb0 + key) * 64 + part * 8) * 2; ldst[2] = MLA_KROW(key) * KPITCH + 256 + part * 16; } \
        _Pragma("unroll") for (int i = 0; i < 2; ++i) { const unsigned c3 = t2 + i * NTHR, dv = c3 >> 3, part = c3 & 7; gsrc[3 + i] = (unsigned)WS_VT + ((h * 128 + dv) * (unsigned)T_ + rb0 + part * 8) * 2; ldst[3 + i] = 2 * KSLOT + dv * VPITCH + part * 16; } }
#define MLA_LOAD(tile0) do { MLA_MAP(); (void)ldst; _Pragma("unroll") for (int sl = 0; sl < 2; ++sl) { const unsigned tt = (unsigned)((tile0) + sl); \
        pf[sl * 5 + 0] = *(const u32x4*)(ws + (size_t)(gsrc[0] + tt * 131072u)); pf[sl * 5 + 1] = *(const u32x4*)(ws + (size_t)(gsrc[1] + tt * 131072u)); pf[sl * 5 + 2] = *(const u32x4*)(ws + (size_t)(gsrc[2] + tt * 8192u)); \
        pf[sl * 5 + 3] = *(const u32x4*)(ws + (size_t)(gsrc[3] + tt * 128u)); pf[sl * 5 + 4] = *(const u32x4*)(ws + (size_t)(gsrc[4] + tt * 128u)); } } while (0)
#define MLA_STORE() do { MLA_MAP(); (void)gsrc; _Pragma("unroll") for (int sl = 0; sl < 2; ++sl) { \
        *(LAS u32x4*)(lds + sl * KSLOT + ldst[0]) = pf[sl * 5 + 0]; *(LAS u32x4*)(lds + sl * KSLOT + ldst[1]) = pf[sl * 5 + 1]; *(LAS u32x4*)(lds + sl * KSLOT + ldst[2]) = pf[sl * 5 + 2]; \
        *(LAS u32x4*)(lds + sl * VSLOT + ldst[3]) = pf[sl * 5 + 3]; *(LAS u32x4*)(lds + sl * VSLOT + ldst[4]) = pf[sl * 5 + 4]; } } while (0)
    __syncthreads();
    MLA_LOAD(0);
    MLA_STORE();
    for (int jp = 0; jp < npairs; ++jp) {
        __syncthreads();
        if (jp + 1 < npairs) MLA_LOAD(2 * (jp + 1));
        const LAS unsigned char* Kt = Kl + grp * KSLOT; const LAS unsigned char* Vt = Vl + grp * VSLOT;
        f32x16 s0, s1;
#pragma unroll
        for (int r = 0; r < 16; ++r) { s0[r] = 0.f; s1[r] = 0.f; }
#pragma unroll
        for (int d0 = 0; d0 < 12; ++d0) {
            const bf16x8 a0 = *(const LAS bf16x8*)(Kt + r32 * KPITCH + d0 * 32 + hi * 16);
            const bf16x8 a1 = *(const LAS bf16x8*)(Kt + (32 + r32) * KPITCH + d0 * 32 + hi * 16);
            s0 = __builtin_amdgcn_mfma_f32_32x32x16_bf16(a0, qf[d0], s0, 0, 0, 0);
            s1 = __builtin_amdgcn_mfma_f32_32x32x16_bf16(a1, qf[d0], s1, 0, 0, 0);
        }
        const bool diag = (jp == npairs - 1); const int qrel = wq * 32 + r32;
        float mx = -INFINITY;
        if (diag) {
#pragma unroll
            for (int r = 0; r < 16; ++r) { const int k0 = grp * 64 + 16 * (r >> 3) + 8 * hi + (r & 7); if (k0 > qrel) s0[r] = -INFINITY; if (k0 + 32 > qrel) s1[r] = -INFINITY; }
        }
#pragma unroll
        for (int r = 0; r < 16; ++r) mx = fmaxf(mx, fmaxf(s0[r], s1[r]));
        mx = fmaxf(mx, __shfl_xor(mx, 32)) * SC;
        const float mnew = fmaxf(mrun, mx);
        if (__any(mnew > mrun)) {
            const float alpha = __builtin_amdgcn_exp2f(mrun - mnew); mrun = mnew; lsum *= alpha;
#pragma unroll
            for (int i = 0; i < 4; ++i)
#pragma unroll
                for (int r = 0; r < 16; ++r) oT[i][r] *= alpha;
        }
        float ps = 0.f;
#pragma unroll
        for (int r = 0; r < 16; ++r) { s0[r] = __builtin_amdgcn_exp2f(__builtin_fmaf(s0[r], SC, -mrun)); s1[r] = __builtin_amdgcn_exp2f(__builtin_fmaf(s1[r], SC, -mrun)); ps += s0[r] + s1[r]; }
        lsum += ps;
#pragma unroll
        for (int kb = 0; kb < 2; ++kb)
#pragma unroll
            for (int hf = 0; hf < 2; ++hf) {
                u32x4 pw;
                if (kb == 0) { pw.x = cvt_pk_bf16(s0[8 * hf + 0], s0[8 * hf + 1]); pw.y = cvt_pk_bf16(s0[8 * hf + 2], s0[8 * hf + 3]); pw.z = cvt_pk_bf16(s0[8 * hf + 4], s0[8 * hf + 5]); pw.w = cvt_pk_bf16(s0[8 * hf + 6], s0[8 * hf + 7]); }
                else { pw.x = cvt_pk_bf16(s1[8 * hf + 0], s1[8 * hf + 1]); pw.y = cvt_pk_bf16(s1[8 * hf + 2], s1[8 * hf + 3]); pw.z = cvt_pk_bf16(s1[8 * hf + 4], s1[8 * hf + 5]); pw.w = cvt_pk_bf16(s1[8 * hf + 6], s1[8 * hf + 7]); }
                const bf16x8 pb = __builtin_bit_cast(bf16x8, pw);
                const int kbase = kb * 32 + 16 * hf + 8 * hi;
#pragma unroll
                for (int dvb = 0; dvb < 4; ++dvb) {
                    const bf16x8 av = *(const LAS bf16x8*)(Vt + (dvb * 32 + r32) * VPITCH + kbase * 2);
                    oT[dvb] = __builtin_amdgcn_mfma_f32_32x32x16_bf16(av, pb, oT[dvb], 0, 0, 0);
                }
            }
        __syncthreads();
        if (jp + 1 < npairs) MLA_STORE();
    }
#undef MLA_LOAD
#undef MLA_STORE
#undef MLA_MAP
#undef MLA_KROW
    __syncthreads();
    LAS float* cb = (LAS float*)lds + (size_t)wq * 66 * 64 + lane;
    if (grp == 1) {
        cb[0] = mrun; cb[64] = lsum;
#pragma unroll
        for (int i = 0; i < 4; ++i)
#pragma unroll
            for (int r = 0; r < 16; ++r) cb[(2 + i * 16 + r) * 64] = oT[i][r];
    }
    __syncthreads();
    if (grp == 0) {
        const float m1 = cb[0], l1 = cb[64];
        const float mN = fmaxf(mrun, m1), w0 = __builtin_amdgcn_exp2f(mrun - mN), w1 = __builtin_amdgcn_exp2f(m1 - mN);
        float lt = lsum * w0 + l1 * w1; lt += __shfl_xor(lt, 32);
        const float inv = 1.0f / lt;
        bf16_t* op = OM + qrow * 2048 + h * 128;
#pragma unroll
        for (int i = 0; i < 4; ++i)
#pragma unroll
            for (int rq = 0; rq < 4; ++rq) {
                float o[4];
#pragma unroll
                for (int j = 0; j < 4; ++j) { const int r = rq * 4 + j; o[j] = (oT[i][r] * w0 + cb[(2 + i * 16 + r) * 64] * w1) * inv; }
                u32x2 w; w.x = cvt_pk_bf16(o[0], o[1]); w.y = cvt_pk_bf16(o[2], o[3]);
                *(u32x2*)(op + i * 32 + 8 * rq + 4 * hi) = w;
            }
    }
    __syncthreads();
}

constexpr int NS = 19;
struct Extra { const bf16_t* A1; const bf16_t* B1; int M1, N1; const bf16_t* A2; const bf16_t* B2; int M2, N2; };
template <class Epi>
__device__ __forceinline__ void run_gemm(LAS unsigned char* lds, const bf16_t* A, int lda, const bf16_t* Bt, int ldb, int M, int N, int K,
                                         int nz, int nzh, long sAb, long sAh, long sBb, long sBh, const Epi& E, const Extra X = Extra{nullptr, nullptr, 256, 0, nullptr, nullptr, 256, 0}, const float* ssp = nullptr, int fmode = 0, int fz = 0, int fpm = 0) {
    const int nM1 = X.M1 / 256, cnt1 = nM1 * (X.N1 / 256), nM2 = X.M2 / 256, cnt2 = nM2 * (X.N2 / 256);
    pg8::Gemm g{A, Bt, M, N, K, lda, ldb, nz, nzh, sAb, sAh, sBb, sBh, X.A1, X.B1, nM1, cnt1, X.A2, X.B2, nM2, cnt2};
    int bidx = (int)blockIdx.x; asm volatile("" : "+s"(bidx));
    pg8::StaticOrder S; S.init(M, N, nz, (int)gridDim.x, bidx, nM1, cnt1, nM2, cnt2); S.fmode = fmode; S.fz = fz; S.fpm = fpm;
    if (ssp) {
        LAS float* rsl = (LAS float*)(lds + LDS_RS_OFF); const int t2 = tid_opaque(); pg8::Unit u;
        for (int i = 0; S.next(i, u); ++i) if (u.grp == 0 && i < 14) {
            const int r = t2 >> 1; const f32x4* pp = (const f32x4*)(ssp + ((size_t)u.z * M + u.pm * 256 + r) * 32 + (t2 & 1) * 16);
            f32x4 a4 = pp[0] + pp[1] + pp[2] + pp[3]; float sm = (a4[0] + a4[1]) + (a4[2] + a4[3]); sm += __shfl_xor(sm, 1);
            if ((t2 & 1) == 0) rsl[i * 256 + r] = 1.0f / sqrtf(sm * (1.0f / 2048.0f) + EPS_);
        }
        __syncthreads();
    }

#ifndef NO_GEMM
    pg8::gemm_phase<Epi>(lds, g, S, E);
#endif

}

__global__ void __launch_bounds__(NTHR, 2) mega(Args a) {
    extern __shared__ __attribute__((aligned(16))) unsigned char lds_raw[];
    LAS unsigned char* lds = (LAS unsigned char*)lds_raw;
    cg::grid_group grid = cg::this_grid();
    unsigned char* ws = a.ws;
    const int G = gridDim.x, blk = blockIdx.x;
    const int NGW = G * 8;
    if (threadIdx.x < 8) ((LAS unsigned*)(lds + LDS_ST_OFF))[threadIdx.x] = 0u;
    __syncthreads();
    const XcdBarrier xbar = xcd_barrier_post((unsigned*)(ws + WS_CTL), (volatile LAS unsigned*)(lds + LDS_ST_OFF));

#pragma unroll 1
    for (int step = a.lo; step < a.hi; ++step) {
        { const int s_ = step % NS; if (step < 2 * NS && (s_ == 3 || s_ == 10 || s_ == 16 || s_ == 13 || s_ == 14 || s_ == 11)) continue; }
        if (step == 2 * NS && G == 256) break;
        if (step > a.lo) { if (a.hi > 1000) grid.sync(); else xcd_barrier(xbar); }
        const int tid = tid_opaque(), lane = tid & 63, wave = __builtin_amdgcn_readfirstlane(tid >> 6);
        const int gw = blk * 8 + wave;
        bf16_t* XN = (bf16_t*)(ws + WS_XN); bf16_t* HBF = (bf16_t*)(ws + WS_HBF);
        if (step == 2 * NS) {
            for (int t = gw; t < T_; t += NGW) rms_row_f32(a.out + (size_t)t * D_, a.in[I_FINN], lane);
            continue;
        }
        const int l = step / NS, s = step % NS;
        const float* hsrc = (l == 0) ? a.in[I_X] : a.out;
        switch (s) {
        case 0: {
            LAS float* scr = (LAS float*)(lds + wave * 16384);
#pragma unroll 1
            for (int j = 0; j < 16; ++j) {
                if (l == 1 && (j == 0 || j == 1 || j == 9 || j == 10 || j == 13)) continue;
                convert_job(a, l, j, scr, gw, NGW, lane);
            }
            if (l == 0) {
                for (int e = blk * NTHR + tid; e < S_ * 32; e += G * NTHR) {
                    const int pos = e >> 5, i = e & 31;
                    double invf = 1.0;
                    for (int k = 0; k < i; ++k) invf *= 0.74989420933245582730;
                    const double rev = (double)pos * invf * 0.15915494309189533577;
                    const float fr = (float)(rev - floor(rev));
                    ((f32x2*)(ws + WS_CS))[e] = (f32x2){__builtin_amdgcn_cosf(fr), __builtin_amdgcn_sinf(fr)};
                }
            }
            for (int r = gw; r < 512; r += NGW) rms_row_bf16(a.in[I_MEM] + (size_t)r * D_, a.in[I_MEMN] + l * D_, (bf16_t*)(ws + WS_MEMN) + (size_t)r * D_, lane);
            if (l == 0) {
                float* SS = (float*)(ws + WS_SS);
                for (int t = gw; t < T_; t += NGW) {
                    const f32x4* xr = (const f32x4*)(a.in[I_X] + (size_t)t * D_) + lane; u32x2* o8 = (u32x2*)(HBF + (size_t)t * D_) + lane; float sq = 0.f;
#pragma unroll
                    for (int j = 0; j < 8; ++j) { const f32x4 v = xr[64 * j]; sq += (v[0] * v[0] + v[1] * v[1]) + (v[2] * v[2] + v[3] * v[3]);
                        u32x2 w; w.x = cvt_pk_bf16(v[0], v[1]); w.y = cvt_pk_bf16(v[2], v[3]); o8[64 * j] = w; }
                    sq = wave_sum(sq); if (lane < 32) SS[(size_t)t * 32 + lane] = (lane == 0) ? sq : 0.f;
                }
            }
        } break;
        case 1: case 17: {
            pg8::EpiSwiglu E; E.nzh = 1; E.sCb = 0; E.sCh = 0; E.O1 = nullptr; E.ldc1 = 0; E.O2 = nullptr; E.ldc2 = 0; E.O = (bf16_t*)(ws + WS_HB); E.ldc = F_;
            E.rowss = (const LAS float*)(lds + LDS_RS_OFF); const float* ssp = (const float*)(ws + WS_SS) + (size_t)(l * 4 + (s == 1 ? 0 : 3)) * T_ * 32;
            Extra X{(const bf16_t*)(ws + WS_MEMN), (const bf16_t*)(ws + WS_WXK), 512, s == 1 ? D_ : 0, (const bf16_t*)(ws + WS_MEMN), (const bf16_t*)(ws + WS_WXV), 512, s == 1 ? D_ : 0};
            E.O1 = (bf16_t*)(ws + WS_KM); E.ldc1 = D_; E.O2 = (bf16_t*)(ws + WS_VMT); E.ldc2 = D_;
            run_gemm(lds, HBF, D_, (const bf16_t*)(ws + (s == 1 ? WS_W1I : WS_W2I)), D_, T_, 2 * F_, D_, 1, 1, 0, 0, 0, 0, E, X, ssp);
            if (s == 17 && l == 0 && G == 256 && blk >= 128) {
                __syncthreads(); LAS float* scr = (LAS float*)(lds + wave * 16384);
                convert_job(a, 1, 9, scr, (blk - 128) * 8 + wave, 128 * 8, lane); convert_job(a, 1, 10, scr, (blk - 128) * 8 + wave, 128 * 8, lane); convert_job(a, 1, 13, scr, (blk - 128) * 8 + wave, 128 * 8, lane);
            }
        } break;
        case 2: case 18: {
            pg8::EpiResid E; E.nzh = 1; E.sCb = 0; E.sCh = 0; E.O1 = nullptr; E.ldc1 = 0; E.O2 = nullptr; E.ldc2 = 0; E.resid = (s == 2) ? hsrc : a.out; E.out = a.out; E.ldc = D_; E.zrows = 0; E.scale = 0.5f; E.hb = HBF; E.ss = (float*)(ws + WS_SS) + (size_t)(s == 2 ? l * 4 + 1 : (l + 1) * 4) * T_ * 32;
            if (s == 18 && l == 1 && G == 256) {
                pg8::EpiFinal EF; EF.nzh = 1; EF.sCb = 0; EF.sCh = 0; EF.O1 = nullptr; EF.ldc1 = 0; EF.O2 = nullptr; EF.ldc2 = 0; EF.resid = a.out; EF.out = a.out; EF.g = a.in[I_FINN];
                EF.xpart = (float*)(ws + WS_SS) + (size_t)8 * T_ * 32; EF.cnt = (unsigned*)(ws + WS_CTL) + CW_PANEL; EF.tab = (LAS float*)(lds + LDS_RS_OFF); EF.ldc = D_; EF.scale = 0.5f;
                run_gemm(lds, (const bf16_t*)(ws + WS_HB), F_, (const bf16_t*)(ws + WS_W2O), F_, T_, D_, F_, 1, 1, 0, 0, 0, 0, EF);
            } else
            run_gemm(lds, (const bf16_t*)(ws + WS_HB), F_, (const bf16_t*)(ws + (s == 2 ? WS_W1O : WS_W2O)), F_, T_, D_, F_, 1, 1, 0, 0, 0, 0, E);
        } break;
        case 3: case 10: case 16: {
            const float* g = a.in[s == 3 ? I_MIXN : (s == 10 ? I_XN : I_F2N)] + l * D_;
            for (int t = gw; t < T_; t += NGW) rms_row_bf16(a.out + (size_t)t * D_, g, XN + (size_t)t * D_, lane);
        } break;
        case 4: {
            pg8::EpiBf16 E; E.nzh = 1; E.sCb = 0; E.sCh = 0; E.O1 = nullptr; E.ldc1 = 0; E.O2 = nullptr; E.ldc2 = 0; E.O = (bf16_t*)(ws + WS_Z); E.ldc = ZP; E.scale = 1.f; E.rowss = (const LAS float*)(lds + LDS_RS_OFF);
            run_gemm(lds, HBF, D_, (const bf16_t*)(ws + WS_WIN), D_, T_, ZP, D_, 1, 1, 0, 0, 0, 0, E, Extra{nullptr, nullptr, 256, 0, nullptr, nullptr, 256, 0}, (const float*)(ws + WS_SS) + (size_t)(l * 4 + 1) * T_ * 32);
            if (l == 0 && G == 256 && blk >= 32) {
                __syncthreads(); LAS float* scr = (LAS float*)(lds + wave * 16384);
                convert_job(a, 1, 0, scr, (blk - 32) * 8 + wave, 224 * 8, lane); convert_job(a, 1, 1, scr, (blk - 32) * 8 + wave, 224 * 8, lane);
            }
        } break;
        case 5: {

#ifndef NO_MIXROW
 for (int t = gw; t < T_; t += NGW) mixer_row(a, l, t, lane);
#endif


#ifndef NO_GLA
 for (int u = blk; u < 512; u += G) gla_p1(a, l, u, (LAS float*)lds);
#endif

        } break;
        case 6: {
            for (int u = blk; u < 256; u += G) gla_p2(a, u);
            pg8::EpiBf16 E; E.nzh = 1; E.sCb = 0; E.sCh = 0; E.O1 = nullptr; E.ldc1 = 0; E.O2 = nullptr; E.ldc2 = 0; E.scale = 1.f; E.rowss = nullptr;
            E.O = (bf16_t*)(ws + WS_QB); E.ldc = 1536; E.O1 = (bf16_t*)(ws + WS_KN); E.ldc1 = 1024; E.O2 = (bf16_t*)(ws + WS_VT); E.ldc2 = T_;
            Extra X{(const bf16_t*)(ws + WS_CKVN), (const bf16_t*)(ws + WS_WUK), T_, 1024, (const bf16_t*)(ws + WS_WUV), (const bf16_t*)(ws + WS_CKVN), 1024, T_};
            run_gemm(lds, (const bf16_t*)(ws + WS_CQN), 512, (const bf16_t*)(ws + WS_WUQ), 512, T_, 1536, 512, 1, 1, 0, 0, 0, 0, E, X);
            pg8::EpiBf16 E3; E3.O1 = nullptr; E3.ldc1 = 0; E3.O2 = nullptr; E3.ldc2 = 0; E3.nzh = 4; E3.sCb = (long)1024 * D_; E3.sCh = (long)256 * D_; E3.O = (bf16_t*)(ws + WS_QX); E3.ldc = D_; E3.scale = 1.f; E3.rowss = nullptr;
            run_gemm(lds, (const bf16_t*)(ws + WS_KM), D_, (const bf16_t*)(ws + WS_WXQ), D_, 256, D_, 512, 8, 4, (long)256 * D_, 512, 0, 512, E3);
            E3.sCb = (long)D_ * 1024; E3.sCh = 256; E3.O = (bf16_t*)(ws + WS_OX); E3.ldc = 1024;
            run_gemm(lds, (const bf16_t*)(ws + WS_WXO), D_, (const bf16_t*)(ws + WS_VMT), D_, D_, 256, 512, 8, 4, 0, 512, (long)256 * D_, 512, E3);
        } break;
        case 7: {
            for (int c = blk; c < 256; c += G) { const int bh = c >> 4, x = c & 15;
#ifndef NO_MLA
 mla_unit(a, bh >> 3, bh & 7, x, lds); mla_unit(a, bh >> 3, bh & 7, 31 - x, lds);
#endif
 }

#ifndef NO_GLA
 for (int u = blk; u < 512; u += G) gla_p3(a, l, u, (LAS float*)lds);
#endif

            __syncthreads();
        } break;
        case 8: {
            pg8::EpiGate3 E; E.nzh = 1; E.sCb = 0; E.sCh = 0; E.O1 = nullptr; E.ldc1 = 0; E.O2 = nullptr; E.ldc2 = 0;
            E.Zg = (const bf16_t*)(ws + WS_Z) + OFF_GATE; E.bg = a.in[I_BGATE] + l * 3 * D_; E.XN = XN;
            run_gemm(lds, (const bf16_t*)(ws + WS_ACT), D_, (const bf16_t*)(ws + WS_WPM), D_, T_, D_, D_, 1, 1, 0, 0, 0, 0, E);
        } break;
        case 9: case 15: {
            pg8::EpiResid E; E.nzh = 1; E.sCb = 0; E.sCh = 0; E.O1 = nullptr; E.ldc1 = 0; E.O2 = nullptr; E.ldc2 = 0; E.resid = a.out; E.out = a.out; E.ldc = D_; E.zrows = 0; E.scale = 1.f; E.hb = HBF; E.ss = (float*)(ws + WS_SS) + (size_t)(l * 4 + (s == 9 ? 2 : 3)) * T_ * 32;
            if (s == 9) run_gemm(lds, (const bf16_t*)XN, D_, (const bf16_t*)(ws + WS_WMO), D_, T_, D_, D_, 1, 1, 0, 0, 0, 0, E);
            else { E.zrows = S_;
                run_gemm(lds, (const bf16_t*)(ws + WS_PX), 1024, (const bf16_t*)(ws + WS_OX), 1024, S_, D_, 1024, 2, 1, (long)S_ * 1024, 0, (long)D_ * 1024, 0, E); }
        } break;
        case 11: {
            pg8::EpiBf16 E; E.nzh = 1; E.sCb = 0; E.sCh = 0; E.O1 = nullptr; E.ldc1 = 0; E.O2 = nullptr; E.ldc2 = 0; E.O = (bf16_t*)(ws + WS_QX); E.ldc = D_; E.scale = 1.f; E.rowss = (const LAS float*)(lds + LDS_RS_OFF);
            run_gemm(lds, HBF, D_, (const bf16_t*)(ws + WS_WXQ), D_, T_, D_, D_, 1, 1, 0, 0, 0, 0, E, Extra{nullptr, nullptr, 256, 0, nullptr, nullptr, 256, 0}, (const float*)(ws + WS_SS) + (size_t)(l * 4 + 2) * T_ * 32);
        } break;
        case 12: {
            pg8::EpiSoftmax E; E.O1 = nullptr; E.ldc1 = 0; E.O2 = nullptr; E.ldc2 = 0; E.nzh = 1; E.sCb = (long)S_ * 1024; E.sCh = 0; E.P = (bf16_t*)(ws + WS_PX); E.red = (LAS float*)(lds + LDS_RS_OFF + 4096);
            E.rowss = (const LAS float*)(lds + LDS_RS_OFF); E.ldc = 1024; E.scale = 0.044194173824159216f;
            run_gemm(lds, HBF, D_, (const bf16_t*)(ws + WS_QX), D_, S_, 1024, D_, 2, 1, (long)S_ * D_, 0, (long)1024 * D_, 0, E,
                     Extra{nullptr, nullptr, 256, 0, nullptr, nullptr, 256, 0}, (const float*)(ws + WS_SS) + (size_t)(l * 4 + 2) * T_ * 32);
        } break;
        default: break;
        }
    }
}

extern "C" void kernel_launch(void* const* d_in, const int* in_sizes, int n_in, void* d_out, int out_size, void* d_ws, size_t ws_size, hipStream_t stream) {
    static int grid = 0;
    if (grid == 0) {
        if (n_in != 29 || out_size != T_ * D_ || ws_size < WS_END) { fprintf(stderr, "kernel_launch: unexpected problem (n_in %d out %d ws %zu need %zu)\n", n_in, out_size, ws_size, (size_t)WS_END); grid = -1; return; }
        int dev = 0, cus = 0, per_cu = 0;
        (void)hipGetDevice(&dev); (void)hipDeviceGetAttribute(&cus, hipDeviceAttributeMultiprocessorCount, dev);
        if (hipFuncSetAttribute((const void*)mega, hipFuncAttributeMaxDynamicSharedMemorySize, LDS_BYTES) != hipSuccess) { fprintf(stderr, "kernel_launch: hipFuncSetAttribute failed\n"); grid = -1; return; }
        if (hipOccupancyMaxActiveBlocksPerMultiprocessor(&per_cu, (const void*)mega, NTHR, LDS_BYTES) != hipSuccess || per_cu < 1) { fprintf(stderr, "kernel_launch: occupancy query says %d\n", per_cu); per_cu = 1; }
        (void)hipGetLastError();
        grid = cus;
    }
    if (grid < 0) return;
    if (hipMemsetAsync((char*)d_ws + WS_CTL, 0, CTL_BYTES, stream) != hipSuccess) { fprintf(stderr, "kernel_launch: memset failed\n"); return; }
    Args a{};
    for (int i = 0; i < 29; ++i) a.in[i] = (const float*)d_in[i];
    a.out = (float*)d_out; a.ws = (unsigned char*)d_ws; a.lo = 0; a.hi = 2 * NS + 1;
    void* args[] = {&a};
    hipError_t e = hipLaunchCooperativeKernel((const void*)mega, dim3(grid), dim3(NTHR), args, LDS_BYTES, stream);
    if (e != hipSuccess) fprintf(stderr, "cooperative launch failed: %s (grid %d)\n", hipGetErrorString(e), grid);
}
```
